# Optimizing an MI355X kernel written in HIP

```python
import math
import jax, jax.numpy as jnp
from jax import lax
import numpy as np

D_MODEL = 2048
BATCH = 4
SEQ = 2048
DEPTH = 4

N_BRANCHES = 3
POOL_WINDOWS = (2, 4, 8, 16)
N_POOL_GROUPS = 4
POOL_DIM = D_MODEL // 2
POOL_GROUP_DIM = POOL_DIM // N_POOL_GROUPS
CONV_DIM = D_MODEL // 2
CONV_WIDTH = 3
N_HEADS = 8
HEAD_DIM = 128
N_KV_HEADS = 2
GROUP = N_HEADS // N_KV_HEADS
ATTN_DIM = N_HEADS * HEAD_DIM
IDX_HEADS = 16
IDX_DIM = 64
TOPK_MAX = 256
Q_BLOCK = 128
NUM_BUCKETS = 32
MAX_EXACT = NUM_BUCKETS // 2
MAX_DISTANCE = 128
BRANCH_DIM = D_MODEL // 2
MLP_HIDDEN = 4 * D_MODEL
NORM_EPS = 1e-6
IN_SPLITS = (POOL_DIM, CONV_DIM, CONV_DIM, CONV_DIM, ATTN_DIM, N_KV_HEADS * HEAD_DIM,
             N_KV_HEADS * HEAD_DIM, IDX_HEADS * IDX_DIM, IDX_DIM, IDX_HEADS)
IN_WIDTH = sum(IN_SPLITS)

kernel_name = 'hybrid_gated_pool_conv_dsa_block'


def _split_points():
    pts, acc = [], 0
    for w in IN_SPLITS[:-1]:
        acc += w
        pts.append(acc)
    return pts


def rmsnorm(x, g):
    xf = x.astype(jnp.float32)
    y = xf * lax.rsqrt(jnp.mean(jnp.square(xf), axis=-1, keepdims=True) + NORM_EPS)
    return (y * g.astype(jnp.float32)).astype(x.dtype)


def t5_bucket(dist):
    n = jnp.maximum(dist, 0)
    nf = jnp.maximum(n, 1).astype(jnp.float32)
    large = MAX_EXACT + (jnp.log(nf / MAX_EXACT) / math.log(MAX_DISTANCE / MAX_EXACT)
                         * (NUM_BUCKETS - MAX_EXACT)).astype(jnp.int32)
    large = jnp.minimum(large, NUM_BUCKETS - 1)
    return jnp.where(n < MAX_EXACT, n, large)


def pool_mixer(u, pool_w, pool_scale):
    B, S, _ = u.shape
    ug = u.astype(jnp.float32).reshape(B, S, N_POOL_GROUPS, POOL_GROUP_DIM)
    c0 = jnp.concatenate([jnp.zeros((B, 1, N_POOL_GROUPS, POOL_GROUP_DIM), jnp.float32),
                          jnp.cumsum(ug, axis=1)], axis=1)
    t = jnp.arange(S)
    win = jnp.array(POOL_WINDOWS, jnp.int32)
    lo = jnp.maximum(t[:, None] + 1 - win[None, :], 0)
    g_ar = jnp.arange(N_POOL_GROUPS)[None, :]
    window_sum = c0[:, 1:] - c0[:, lo, g_ar]
    cnt = (t[:, None] + 1 - lo).astype(jnp.float32)[None, :, :, None]
    d = window_sum / cnt - ug
    y = jnp.einsum('bsgc,gcd->bsgd', d, pool_w.astype(jnp.float32))
    return (y.reshape(B, S, POOL_DIM) * pool_scale.astype(jnp.float32)).astype(u.dtype)


def conv_mixer(u, gate_c, gate_b, conv_w):
    z = gate_c * u
    y = lax.conv_general_dilated(z, conv_w[:, None, :], window_strides=(1,),
                                 padding=[(CONV_WIDTH - 1, 0)],
                                 dimension_numbers=('NWC', 'WIO', 'NWC'),
                                 feature_group_count=CONV_DIM)
    return gate_b * y


def sparse_attention(q, k, v, q_idx, k_idx, w_idx, rel_bias):
    B, S = q.shape[0], q.shape[1]
    topk = min(TOPK_MAX, S // 4)
    nblk = S // Q_BLOCK
    key_pos = jnp.arange(S)
    k_idx32 = k_idx.astype(jnp.float32)
    table = rel_bias.astype(jnp.float32)

    def to_blocks(a):
        return jnp.moveaxis(a.reshape((B, nblk, Q_BLOCK) + a.shape[2:]), 1, 0)

    def block_fn(args):
        qb, qib, wb, blk = args
        q_pos = blk * Q_BLOCK + jnp.arange(Q_BLOCK)
        dots = jnp.einsum('bthd,bsd->bths', qib.astype(jnp.float32), k_idx32)
        score = jnp.einsum('bth,bths->bts', wb.astype(jnp.float32) * IDX_HEADS ** -0.5,
                           jax.nn.relu(dots))
        causal = key_pos[None, :] <= q_pos[:, None]
        score = jnp.where(causal[None], score, -jnp.inf)
        _, idx = lax.top_k(score, topk)
        k_sel = jax.vmap(lambda kb, ib: kb[ib])(k, idx)
        v_sel = jax.vmap(lambda vb, ib: vb[ib])(v, idx)
        qg = qb.reshape(B, Q_BLOCK, N_KV_HEADS, GROUP, HEAD_DIM).astype(jnp.float32)
        logits = jnp.einsum('btgrd,btkgd->btgrk', qg, k_sel.astype(jnp.float32)) * HEAD_DIM ** -0.5
        dist = q_pos[None, :, None] - idx
        bias = table[t5_bucket(dist)]
        bias = bias.reshape(B, Q_BLOCK, topk, N_KV_HEADS, GROUP).transpose(0, 1, 3, 4, 2)
        logits = jnp.where((dist >= 0)[:, :, None, None, :], logits + bias, -jnp.inf)
        p = jax.nn.softmax(logits, axis=-1)
        o = jnp.einsum('btgrk,btkgd->btgrd', p, v_sel.astype(jnp.float32))
        return o.reshape(B, Q_BLOCK, ATTN_DIM).astype(q.dtype)

    out = lax.map(block_fn, (to_blocks(q), to_blocks(q_idx), to_blocks(w_idx),
                             jnp.arange(nblk, dtype=jnp.int32)))
    return jnp.moveaxis(out, 0, 1).reshape(B, S, ATTN_DIM)


def setup_inputs(seed: int = 0) -> dict:
    key = jax.random.key(seed)
    ks = jax.random.split(key, 13)

    def nrm(k, shape, scale):
        return jax.random.normal(k, shape, jnp.float32) * scale

    return {
        'x': nrm(ks[0], (BATCH, SEQ, D_MODEL), 1.0),
        'norm_gains': 1.0 + nrm(ks[1], (DEPTH, 4, D_MODEL), 0.05),
        'w_in': nrm(ks[2], (DEPTH, D_MODEL, IN_WIDTH), D_MODEL ** -0.5),
        'pool_w': nrm(ks[3], (DEPTH, N_POOL_GROUPS, POOL_GROUP_DIM, POOL_GROUP_DIM), POOL_GROUP_DIM ** -0.5),
        'pool_scale': 1.0 + nrm(ks[4], (DEPTH, POOL_DIM), 0.05),
        'conv_w': nrm(ks[5], (DEPTH, CONV_WIDTH, CONV_DIM), CONV_WIDTH ** -0.5),
        'rel_bias': nrm(ks[6], (NUM_BUCKETS, N_HEADS), 0.5),
        'w_branch': nrm(ks[7], (DEPTH, N_BRANCHES, BRANCH_DIM, D_MODEL), BRANCH_DIM ** -0.5),
        'w_gate': nrm(ks[8], (DEPTH, D_MODEL, N_BRANCHES * D_MODEL), D_MODEL ** -0.5),
        'b_gate': nrm(ks[9], (DEPTH, N_BRANCHES, D_MODEL), 0.1),
        'w_out': nrm(ks[10], (DEPTH, D_MODEL, D_MODEL), D_MODEL ** -0.5),
        'w_up': nrm(ks[11], (DEPTH, D_MODEL, MLP_HIDDEN), D_MODEL ** -0.5),
        'w_down': nrm(ks[12], (DEPTH, MLP_HIDDEN, D_MODEL), MLP_HIDDEN ** -0.5),
    }


def reference(x, norm_gains, w_in, pool_w, pool_scale, conv_w, rel_bias, w_branch,
              w_gate, b_gate, w_out, w_up, w_down):
    B, S, D = x.shape
    pts = _split_points()
    for l in range(DEPTH):
        g = norm_gains[l]
        h = rmsnorm(x, g[0])
        proj = h @ w_in[l]
        (u_pool, u_conv, c_gate, b_gate_conv, q, k, v, qi, ki, wi) = jnp.split(proj, pts, axis=-1)
        y_pool = pool_mixer(u_pool, pool_w[l], pool_scale[l])
        y_conv = conv_mixer(u_conv, c_gate, b_gate_conv, conv_w[l])
        y_attn = sparse_attention(q.reshape(B, S, N_HEADS, HEAD_DIM),
                                  k.reshape(B, S, N_KV_HEADS, HEAD_DIM),
                                  v.reshape(B, S, N_KV_HEADS, HEAD_DIM),
                                  qi.reshape(B, S, IDX_HEADS, IDX_DIM), ki, wi, rel_bias)
        branches = jnp.stack([y_pool, y_conv, y_attn], axis=2)
        up = jnp.einsum('bsnc,ncd->bsnd', branches, w_branch[l])
        gates = jax.nn.sigmoid((h @ w_gate[l]).reshape(B, S, N_BRANCHES, D) + b_gate[l])
        mixed = jnp.sum(gates * up, axis=2) @ w_out[l]
        x = x + rmsnorm(mixed, g[1])
        h = rmsnorm(x, g[2])
        m = jnp.square(jax.nn.relu(h @ w_up[l])) @ w_down[l]
        x = x + rmsnorm(m, g[3])
    return x
```

```cpp
#include <hip/hip_runtime.h>
#include <cstdio>
#include <cstdint>

#ifndef MK_SPLIT
#define MK_SPLIT 0
#endif

namespace pg8 {
#define PG8_LAS __attribute__((address_space(3)))
typedef unsigned short bf16_t;
typedef short bf16x8 __attribute__((ext_vector_type(8)));
typedef float f32x4 __attribute__((ext_vector_type(4)));
typedef float f32x2 __attribute__((ext_vector_type(2)));
typedef unsigned u32x4 __attribute__((ext_vector_type(4)));
constexpr int BM = 256, BK = 64, HALF = 128, HTB = HALF * BK * 2  , STAGE_BYTES = 8 * HTB, NXCD = 8, WGM = 8;

__host__ __device__ __forceinline__ int lds_byte(int r, int c) { const int st = (r >> 4) * 2 + (c >> 5), rr = r & 15, cc = c & 31, ob = rr * 64 + cc * 2; return st * 1024 + (ob ^ (((ob >> 9) & 1) << 5)); }
__host__ __device__ __forceinline__ void stage_rc(int b, int& R, int& C) { const int st = b / 1024, sb = b % 1024, swz = sb ^ (((sb >> 9) & 1) << 5); R = (st >> 1) * 16 + swz / 64; C = (st & 1) * 32 + (swz % 64) / 2; }
__host__ __device__ __forceinline__ int perm32(int rho) { const int n = rho >> 4, i = rho & 15; return 8 * (i >> 2) + 4 * n + (i & 3); }

struct Unit { int pm, pn, sub; };
struct Gemm {
    const bf16_t* A; const bf16_t* Bt; int lda, ldb, K; long a_pn, a_sub, b_sub;
    __device__ __forceinline__ const char* pa(const Unit& u) const { return (const char*)(A + ((size_t)u.pm * BM * lda + (size_t)u.pn * a_pn + (size_t)u.sub * a_sub)); }
    __device__ __forceinline__ const char* pb(const Unit& u) const { return (const char*)(Bt + ((size_t)u.pn * BM * ldb + (size_t)u.sub * b_sub)); }
};

struct StaticOrder {
    int nM, nN, nwg, G, c, subs;
    __host__ __device__ void init(int M, int N, int G_, int c_, int subs_ = 1) { nM = M / BM; nN = N / BM; nwg = nM * nN; G = G_; c = c_; subs = subs_; }
    __host__ __device__ bool next(int i, Unit& u) const {
        const int ti = i / subs;
        const long L = (long)ti * G + c; if (L >= nwg) return false;
        int wgid = (int)L; { const int q = nwg / NXCD, r = nwg % NXCD, xcd = wgid % NXCD, off = wgid / NXCD; wgid = (xcd < r ? xcd * (q + 1) : r * (q + 1) + (xcd - r) * q) + off; }
        const int nig = WGM * nN, gid = wgid / nig, fm = gid * WGM, gsz = (nM - fm) < WGM ? (nM - fm) : WGM;
        u.pm = fm + ((wgid % nig) % gsz); u.pn = (wgid % nig) / gsz; u.sub = i - ti * subs; return true;
    }
    __device__ __forceinline__ void a_ready(const Unit&) const {}
    __device__ __forceinline__ void done(const Unit&) const {}
};

typedef __bf16 bf16x2_t __attribute__((ext_vector_type(2)));
__device__ __forceinline__ unsigned cvt_pk_bf16(float lo, float hi) { const f32x2 v = {lo, hi}; return __builtin_bit_cast(unsigned, __builtin_convertvector(v, bf16x2_t)); }
__device__ __forceinline__ float bflo(unsigned w) { return __builtin_bit_cast(float, w << 16); }
__device__ __forceinline__ float bfhi(unsigned w) { return __builtin_bit_cast(float, w & 0xffff0000u); }
__device__ __forceinline__ u32x4 pack8(const f32x4& v0, const f32x4& v1) { u32x4 w; w.x = cvt_pk_bf16(v0[0], v0[1]); w.y = cvt_pk_bf16(v0[2], v0[3]); w.z = cvt_pk_bf16(v1[0], v1[1]); w.w = cvt_pk_bf16(v1[2], v1[3]); return w; }

struct EpiF32 {
    static constexpr bool PERM = false, AFTER_DRAIN = false;
    float* C; int ldc;
    __device__ __forceinline__ void operator()(const f32x4 (&acc)[2][2][4][2], const Unit& u, int wr, int wc, int fr_, int fq_) const {
        int fr = fr_, fq = fq_; asm volatile("" : "+v"(fr), "+v"(fq));
        const int row0 = u.pm * BM + wr * 64 + fr, col0 = u.pn * BM + wc * 32 + 4 * fq;
#pragma unroll
        for (int ai = 0; ai < 2; ++ai)
#pragma unroll
            for (int m = 0; m < 4; ++m) { float* rowp = C + (size_t)(row0 + ai * HALF + m * 16) * ldc + col0;
#pragma unroll
                for (int bj = 0; bj < 2; ++bj)
#pragma unroll
                    for (int n = 0; n < 2; ++n) *(f32x4*)(rowp + bj * HALF + n * 16) = acc[ai][bj][m][n]; }
    }
};
template <int ACT> struct EpiBf16 {
    static constexpr bool PERM = true, AFTER_DRAIN = false;
    bf16_t* O; int ldc; const float* vec;
    __device__ __forceinline__ void operator()(const f32x4 (&acc)[2][2][4][2], const Unit& u, int wr, int wc, int fr_, int fq_) const {
        int fr = fr_, fq = fq_; asm volatile("" : "+v"(fr), "+v"(fq));
        const int row0 = u.pm * BM + wr * 64 + fr, col0 = u.pn * BM + wc * 32 + 8 * fq;
        f32x4 sv[2][2];
        if (ACT == 2) {
#pragma unroll
            for (int bj = 0; bj < 2; ++bj)
#pragma unroll
                for (int n = 0; n < 2; ++n) sv[bj][n] = *(const f32x4*)(vec + col0 + bj * HALF + 4 * n);
        }
#pragma unroll
        for (int ai = 0; ai < 2; ++ai)
#pragma unroll
            for (int m = 0; m < 4; ++m) { bf16_t* rowp = O + (size_t)(row0 + ai * HALF + m * 16) * ldc + col0;
#pragma unroll
                for (int bj = 0; bj < 2; ++bj) { f32x4 v0 = acc[ai][bj][m][0], v1 = acc[ai][bj][m][1];
                    if (ACT == 1) {
#pragma unroll
                        for (int j = 0; j < 4; ++j) { const float a = fmaxf(v0[j], 0.f), b = fmaxf(v1[j], 0.f); v0[j] = a * a; v1[j] = b * b; } }
                    if (ACT == 2) { v0 = v0 * sv[bj][0]; v1 = v1 * sv[bj][1]; }
                    *(u32x4*)(rowp + bj * HALF) = pack8(v0, v1); } }
    }
};
struct EpiProjGate {
    static constexpr bool PERM = true, AFTER_DRAIN = false;
    bf16_t* P; int ldp; bf16_t* Gt; int ldg; const float* bias; int npj;
    __device__ __forceinline__ void operator()(const f32x4 (&acc)[2][2][4][2], const Unit& u, int wr, int wc, int fr_, int fq_) const {
        int fr = fr_, fq = fq_; asm volatile("" : "+v"(fr), "+v"(fq));
        const int row0 = u.pm * BM + wr * 64 + fr;
        if (u.pn < npj) {
            const int col0 = u.pn * BM + wc * 32 + 8 * fq;
#pragma unroll
            for (int ai = 0; ai < 2; ++ai)
#pragma unroll
                for (int m = 0; m < 4; ++m) { bf16_t* rowp = P + (size_t)(row0 + ai * HALF + m * 16) * ldp + col0;
#pragma unroll
                    for (int bj = 0; bj < 2; ++bj) *(u32x4*)(rowp + bj * HALF) = pack8(acc[ai][bj][m][0], acc[ai][bj][m][1]); }
        } else {
            const int col0 = (u.pn - npj) * BM + wc * 32 + 8 * fq;
            f32x4 bv[2][2];
#pragma unroll
            for (int bj = 0; bj < 2; ++bj)
#pragma unroll
                for (int n = 0; n < 2; ++n) bv[bj][n] = *(const f32x4*)(bias + col0 + bj * HALF + 4 * n);
#pragma unroll
            for (int ai = 0; ai < 2; ++ai)
#pragma unroll
                for (int m = 0; m < 4; ++m) { bf16_t* rowp = Gt + (size_t)(row0 + ai * HALF + m * 16) * ldg + col0;
#pragma unroll
                    for (int bj = 0; bj < 2; ++bj) { f32x4 v0 = acc[ai][bj][m][0] + bv[bj][0], v1 = acc[ai][bj][m][1] + bv[bj][1];
#pragma unroll
                        for (int j = 0; j < 4; ++j) { v0[j] = __builtin_amdgcn_rcpf(1.0f + __expf(-v0[j])); v1[j] = __builtin_amdgcn_rcpf(1.0f + __expf(-v1[j])); }
                        *(u32x4*)(rowp + bj * HALF) = pack8(v0, v1); } }
        }
    }
};
struct EpiBranch {
    static constexpr bool PERM = true, AFTER_DRAIN = false;
    const bf16_t* Gt; int ldg; int gsub; float* tmp; bf16_t* O; int ldc; int nsub;
    __device__ __forceinline__ void operator()(const f32x4 (&acc)[2][2][4][2], const Unit& u, int wr, int wc, int fr_, int fq_) const {
        int fr = fr_, fq = fq_; asm volatile("" : "+v"(fr), "+v"(fq));
        const int row0 = u.pm * BM + wr * 64 + fr, col0 = u.pn * BM + wc * 32 + 8 * fq;
#pragma unroll
        for (int ai = 0; ai < 2; ++ai)
#pragma unroll
            for (int m = 0; m < 4; ++m) { const size_t r = (size_t)(row0 + ai * HALF + m * 16);
#pragma unroll
                for (int bj = 0; bj < 2; ++bj) { const int c = col0 + bj * HALF;
                    const u32x4 gw = *(const u32x4*)(Gt + r * ldg + (size_t)u.sub * gsub + c);
                    f32x4 v0 = acc[ai][bj][m][0], v1 = acc[ai][bj][m][1];
                    v0[0] *= bflo(gw.x); v0[1] *= bfhi(gw.x); v0[2] *= bflo(gw.y); v0[3] *= bfhi(gw.y);
                    v1[0] *= bflo(gw.z); v1[1] *= bfhi(gw.z); v1[2] *= bflo(gw.w); v1[3] *= bfhi(gw.w);
                    float* tp = tmp + r * ldc + c;
                    if (u.sub > 0) { v0 = v0 + *(const f32x4*)tp; v1 = v1 + *(const f32x4*)(tp + 4); }
                    if (u.sub < nsub - 1) { *(f32x4*)tp = v0; *(f32x4*)(tp + 4) = v1; }
                    else *(u32x4*)(O + r * ldc + c) = pack8(v0, v1); } }
    }
};

template <class Epi, class Sched, bool ALIGN_EPI = false, bool SP2 = false>
__device__ __forceinline__ void gemm_phase(PG8_LAS unsigned char* lds, const Gemm g_in, const Sched& S, const Epi& E) {
    Gemm g = g_in; asm volatile("" : "+s"(g.A), "+s"(g.Bt));
    int tid_l = threadIdx.x; asm volatile("" : "+v"(tid_l));
    const int tid = tid_l, wid = __builtin_amdgcn_readfirstlane(tid >> 6), lane = tid & 63, wr = wid >> 2, wc = wid & 3, fr = lane & 15, fq = lane >> 4;
    const int K = g.K, nt = K / BK;
    unsigned voffA[2], voffB[2];
#pragma unroll
    for (int i = 0; i < 2; ++i) { int R, C; stage_rc(tid * 16 + i * 8192, R, C); const int Rb = Epi::PERM ? ((R & ~31) + perm32(R & 31)) : R;
        voffA[i] = (unsigned)(R * g.lda + C) * 2u; voffB[i] = (unsigned)(Rb * g.ldb + C) * 2u; }
    const size_t kstep = (size_t)(BK * 2);
    const size_t hstepA = (size_t)HALF * g.lda * 2, hstepB = (size_t)HALF * g.ldb * 2;
    const unsigned ldsw = (unsigned)wid * 1024u;
    const int aoff = lds_byte(wr * 64 + fr, fq * 8), boff = lds_byte(wc * 32 + fr, fq * 8);
#define PG8_SA(b, h) (((b) * 2 + (h)) * HTB)
#define PG8_SB(b, h) ((4 + (b) * 2 + (h)) * HTB)
#define PG8_STAGE(bufoff, gbase, voff) do { _Pragma("unroll") for (int _i = 0; _i < 2; ++_i) \
        __builtin_amdgcn_global_load_lds((const unsigned*)((const char*)(gbase) + (voff)[_i]), (PG8_LAS unsigned*)(lds + (bufoff) + ldsw + _i * 8192), 16, 0, 0); } while (0)
#define PG8_LDA(dst, b, h) do { _Pragma("unroll") for (int m = 0; m < 4; ++m) _Pragma("unroll") for (int k = 0; k < 2; ++k) dst[m][k] = *(const PG8_LAS bf16x8*)(lds + PG8_SA(b, h) + aoff + m * 2048 + k * 1024); } while (0)
#define PG8_LDB(dst, b, h) do { _Pragma("unroll") for (int n = 0; n < 2; ++n) _Pragma("unroll") for (int k = 0; k < 2; ++k) dst[n][k] = *(const PG8_LAS bf16x8*)(lds + PG8_SB(b, h) + boff + n * 2048 + k * 1024); } while (0)
#define PG8_MMA(ai, bj, At, Bt) do { __builtin_amdgcn_s_setprio(1); _Pragma("unroll") for (int m = 0; m < 4; ++m) _Pragma("unroll") for (int n = 0; n < 2; ++n) _Pragma("unroll") for (int k = 0; k < 2; ++k) \
        acc[ai][bj][m][n] = __builtin_amdgcn_mfma_f32_16x16x32_bf16(Bt[n][k], At[m][k], acc[ai][bj][m][n], 0, 0, 0); __builtin_amdgcn_s_setprio(0); } while (0)
#define PG8_WAIT_V(n) asm volatile("s_waitcnt vmcnt(" #n ")" ::: "memory")
#define PG8_WAIT_L(n) asm volatile("s_waitcnt lgkmcnt(" #n ")" ::: "memory")
#define PG8_BAR __builtin_amdgcn_s_barrier()
#define PG8_SCHED __builtin_amdgcn_sched_barrier(0)
    Unit cur, nxt; int ui = 0;
    if (!S.next(0, cur)) return;
    f32x4 acc[2][2][4][2];
#pragma unroll
    for (int a = 0; a < 2; ++a)
#pragma unroll
        for (int b = 0; b < 2; ++b)
#pragma unroll
            for (int m = 0; m < 4; ++m)
#pragma unroll
                for (int n = 0; n < 2; ++n) acc[a][b][m][n] = (f32x4){0.f, 0.f, 0.f, 0.f};
    bf16x8 At[4][2], B0[2][2], B1[2][2];
    const char* cA = g.pa(cur); const char* cB = g.pb(cur);
    S.a_ready(cur);
    if constexpr (SP2) {
        PG8_STAGE(PG8_SB(0, 0), cB, voffB); PG8_STAGE(PG8_SB(0, 1), cB + hstepB, voffB); PG8_STAGE(PG8_SA(0, 0), cA, voffA); PG8_STAGE(PG8_SA(0, 1), cA + hstepA, voffA);
        if (wr == 1) PG8_BAR;
        PG8_WAIT_V(2); PG8_BAR;
        PG8_STAGE(PG8_SB(1, 0), cB + kstep, voffB); PG8_STAGE(PG8_SA(1, 0), cA + kstep, voffA); PG8_STAGE(PG8_SB(1, 1), cB + hstepB + kstep, voffB);
        PG8_WAIT_V(6); PG8_BAR;
    } else {
        PG8_STAGE(PG8_SB(0, 0), cB, voffB); PG8_STAGE(PG8_SA(0, 0), cA, voffA); PG8_STAGE(PG8_SB(0, 1), cB + hstepB, voffB); PG8_STAGE(PG8_SA(0, 1), cA + hstepA, voffA);
        if (wr == 1) PG8_BAR;
        PG8_WAIT_V(4); PG8_BAR;
        PG8_STAGE(PG8_SB(1, 0), cB + kstep, voffB); PG8_STAGE(PG8_SA(1, 0), cA + kstep, voffA); PG8_STAGE(PG8_SB(1, 1), cB + hstepB + kstep, voffB);
        PG8_WAIT_V(6); PG8_BAR;
    }
    for (;;) {
        const bool has_next = S.next(ui + 1, nxt);
        const char* nA = has_next ? g.pa(nxt) : cA; const char* nB = has_next ? g.pb(nxt) : cB;
#pragma unroll 1
        for (int t = 0; t < nt; t += 2) {
            const bool last = (t == nt - 2);
            const char* a1 = cA + (size_t)(t + 1) * kstep;
            const char* a2 = last ? nA : cA + (size_t)(t + 2) * kstep; const char* b2 = last ? nB : cB + (size_t)(t + 2) * kstep;
            const char* a3 = a2 + kstep; const char* b3 = b2 + kstep;
            if (last && has_next) S.a_ready(nxt);
            if constexpr (SP2) {
            PG8_LDB(B0, 0, 0); PG8_LDB(B1, 0, 1); PG8_SCHED; PG8_LDA(At, 0, 0); PG8_STAGE(PG8_SA(1, 1), a1 + hstepA, voffA);
            PG8_WAIT_V(8); PG8_WAIT_L(0); PG8_BAR; PG8_MMA(0, 0, At, B0); PG8_MMA(0, 1, At, B1); PG8_BAR; PG8_SCHED;
            PG8_LDA(At, 0, 1); PG8_STAGE(PG8_SB(0, 0), b2, voffB); PG8_STAGE(PG8_SB(0, 1), b2 + hstepB, voffB); PG8_STAGE(PG8_SA(0, 0), a2, voffA);
            PG8_WAIT_V(8); PG8_WAIT_L(0); PG8_BAR; PG8_MMA(1, 0, At, B0); PG8_MMA(1, 1, At, B1); PG8_BAR; PG8_SCHED;
            PG8_LDB(B0, 1, 0); PG8_LDB(B1, 1, 1); PG8_SCHED; PG8_LDA(At, 1, 0); PG8_STAGE(PG8_SA(0, 1), a2 + hstepA, voffA);
            PG8_WAIT_V(8); PG8_WAIT_L(0); PG8_BAR; PG8_MMA(0, 0, At, B0); PG8_MMA(0, 1, At, B1); PG8_BAR; PG8_SCHED;
            PG8_LDA(At, 1, 1); PG8_STAGE(PG8_SB(1, 0), b3, voffB); PG8_STAGE(PG8_SB(1, 1), b3 + hstepB, voffB); PG8_STAGE(PG8_SA(1, 0), a3, voffA);
            PG8_WAIT_V(8); PG8_WAIT_L(0); PG8_BAR; PG8_MMA(1, 0, At, B0); PG8_MMA(1, 1, At, B1); PG8_BAR; PG8_SCHED;
            } else {
            PG8_LDB(B0, 0, 0); PG8_SCHED; PG8_LDA(At, 0, 0); PG8_STAGE(PG8_SA(1, 1), a1 + hstepA, voffA);
            PG8_WAIT_L(8); PG8_BAR; PG8_WAIT_L(0); PG8_MMA(0, 0, At, B0); PG8_BAR; PG8_SCHED;
            PG8_LDB(B1, 0, 1); PG8_STAGE(PG8_SB(0, 0), b2, voffB);
            PG8_BAR; PG8_WAIT_L(0); PG8_MMA(0, 1, At, B1); PG8_BAR;
            PG8_LDA(At, 0, 1); PG8_STAGE(PG8_SA(0, 0), a2, voffA);
            PG8_BAR; PG8_WAIT_L(0); PG8_MMA(1, 0, At, B0); PG8_BAR; PG8_SCHED;
            PG8_STAGE(PG8_SB(0, 1), b2 + hstepB, voffB);
            PG8_WAIT_V(6); PG8_BAR; PG8_MMA(1, 1, At, B1); PG8_BAR;
            PG8_LDB(B0, 1, 0); PG8_SCHED; PG8_LDA(At, 1, 0); PG8_STAGE(PG8_SA(0, 1), a2 + hstepA, voffA);
            PG8_WAIT_L(8); PG8_BAR; PG8_WAIT_L(0); PG8_MMA(0, 0, At, B0); PG8_BAR; PG8_SCHED;
            PG8_LDB(B1, 1, 1); PG8_STAGE(PG8_SB(1, 0), b3, voffB);
            PG8_BAR; PG8_WAIT_L(0); PG8_MMA(0, 1, At, B1); PG8_BAR;
            PG8_LDA(At, 1, 1); PG8_STAGE(PG8_SA(1, 0), a3, voffA);
            PG8_BAR; PG8_WAIT_L(0); PG8_MMA(1, 0, At, B0); PG8_BAR; PG8_SCHED;
            PG8_STAGE(PG8_SB(1, 1), b3 + hstepB, voffB);
            PG8_WAIT_V(6); PG8_BAR; PG8_MMA(1, 1, At, B1); PG8_BAR;
            }
        }
        if constexpr (ALIGN_EPI) { if (wr == 0) PG8_BAR; }
        if constexpr (!Epi::AFTER_DRAIN) { E(acc, cur, wr, wc, fr, fq); S.done(cur); }
        if (!has_next) break;
#pragma unroll
        for (int a = 0; a < 2; ++a)
#pragma unroll
            for (int b = 0; b < 2; ++b)
#pragma unroll
                for (int m = 0; m < 4; ++m)
#pragma unroll
                    for (int n = 0; n < 2; ++n) acc[a][b][m][n] = (f32x4){0.f, 0.f, 0.f, 0.f};
        cur = nxt; cA = nA; cB = nB; ++ui;
        if constexpr (ALIGN_EPI) { if (wr == 1) PG8_BAR; }
    }
    PG8_WAIT_V(0);
    if constexpr (!ALIGN_EPI) { if (wr == 0) PG8_BAR; }
    PG8_BAR;
    if constexpr (Epi::AFTER_DRAIN) { E.fused(acc, cur, wr, wc, fr, fq, lds, wid, lane); S.done(cur); }
#undef PG8_SA
#undef PG8_SB
#undef PG8_STAGE
#undef PG8_LDA
#undef PG8_LDB
#undef PG8_MMA
#undef PG8_WAIT_V
#undef PG8_WAIT_L
#undef PG8_BAR
#undef PG8_SCHED
}

}

constexpr int NWAVES = 8, NTHR = NWAVES * 64;
constexpr int D = 2048, BATCH = 4, SEQ = 2048, DEPTH = 4, M = BATCH * SEQ;
constexpr int INW = 6736, INWP = 6912, GW = 3 * D, N1 = INWP + GW, FF = 8192, NPJ = INWP / 256;
constexpr int O_UPOOL = 0, O_UCONV = 1024, O_CG = 2048, O_BG = 3072, O_Q = 4096, O_K = 5120, O_V = 5376, O_QI = 5632, O_KI = 6656, O_WI = 6720;
constexpr int NH = 8, HD = 128, IH = 16, IDIM = 64, TOPK = 256;
constexpr float EPS = 1e-6f;
constexpr int NPH = 10;

constexpr size_t MiB = 1u << 20;
constexpr size_t WS_CTL = 0, CTL_ZERO_BYTES = 1 * MiB;
constexpr size_t WS_WCAT1 = 1 * MiB;
constexpr size_t WS_WPOOL = 52 * MiB;
constexpr size_t WS_WBR = 53 * MiB;
constexpr size_t WS_WOUT = 65 * MiB;
constexpr size_t WS_WUP = 73 * MiB;
constexpr size_t WS_WDOWN = 105 * MiB;
constexpr size_t WS_H = 137 * MiB;
constexpr size_t WS_PROJ = 169 * MiB;
constexpr size_t WS_GATES = 277 * MiB;
constexpr size_t WS_ABUF = WS_PROJ;
constexpr size_t WS_DP = 373 * MiB;
constexpr size_t WS_Y = 389 * MiB;
constexpr size_t WS_SC = 437 * MiB;
constexpr size_t WS_MASK = 501 * MiB;
constexpr size_t WS_TMP = 503 * MiB;
constexpr size_t WS_MP = 567 * MiB;
constexpr size_t WS_MX = 599 * MiB;
constexpr size_t WS_END = 663 * MiB;
static_assert(WS_WCAT1 + (size_t)N1 * D * 2 <= WS_WPOOL && WS_PROJ + (size_t)M * INWP * 2 <= WS_GATES && WS_GATES + (size_t)M * GW * 2 <= WS_DP && WS_ABUF + (size_t)M * FF * 2 <= WS_DP, "ws map");
constexpr int CW_BAR = 4096;

constexpr int RING_OFF = 0, RING_BYTES = 131072;
constexpr int LDSCTL_OFF = RING_BYTES, MISC_OFF = LDSCTL_OFF + 320;
constexpr int LDS_BYTES = 147456;

#define GAS __attribute__((address_space(1)))
#define LAS __attribute__((address_space(3)))
typedef unsigned short bf16;
typedef unsigned v4u __attribute__((ext_vector_type(4)));
typedef unsigned v2u __attribute__((ext_vector_type(2)));
typedef float f32x4 __attribute__((ext_vector_type(4)));
#define LDS_WAIT() asm volatile("s_waitcnt lgkmcnt(0)" ::: "memory")
#define VM_WAIT() asm volatile("s_waitcnt vmcnt(0)" ::: "memory")
__device__ __forceinline__ unsigned f2bf(float f) { unsigned u = __builtin_bit_cast(unsigned, f); return (u + 0x7fffu + ((u >> 16) & 1u)) >> 16; }
__device__ __forceinline__ unsigned pk2(float lo, float hi) { return f2bf(lo) | (f2bf(hi) << 16); }
__device__ __forceinline__ float bflo(unsigned w) { return __builtin_bit_cast(float, w << 16); }
__device__ __forceinline__ float bfhi(unsigned w) { return __builtin_bit_cast(float, w & 0xffff0000u); }
__device__ __forceinline__ float bf2f(bf16 b) { return __builtin_bit_cast(float, (unsigned)b << 16); }
__device__ __forceinline__ void unpack8(const v4u w, float (&f)[8]) { f[0] = bflo(w.x); f[1] = bfhi(w.x); f[2] = bflo(w.y); f[3] = bfhi(w.y); f[4] = bflo(w.z); f[5] = bfhi(w.z); f[6] = bflo(w.w); f[7] = bfhi(w.w); }
__device__ __forceinline__ float wave_sum(float v) {
#pragma unroll
    for (int o = 1; o < 64; o <<= 1) v += __shfl_xor(v, o);
    return v;
}

#define XB_TMO      128
#define XB_XCNT(j)  (256  + 64 * (j))
#define XB_XSUB(j)  (1280 + 64 * (j))
#define XB_XGEN(j)  (2304 + 64 * (j))
#define XB_TOP      3328
#define XB_TOPGEN   3392
#define XCD_BAR_WORDS 3456
#define XB_SPIN_CAP (1u << 18)

__device__ __forceinline__ unsigned xb_ld(unsigned* p)              { return __hip_atomic_load(p, __ATOMIC_RELAXED, __HIP_MEMORY_SCOPE_AGENT); }
__device__ __forceinline__ unsigned xb_add(unsigned* p, unsigned v) { return __hip_atomic_fetch_add(p, v, __ATOMIC_RELAXED, __HIP_MEMORY_SCOPE_AGENT); }
__device__ __forceinline__ unsigned xb_xcc_id() { return (unsigned)__builtin_amdgcn_s_getreg((3 << 11) | 20) & 0xFu; }
#define XB_SPIN(cond, bar) do { unsigned _sp = 0; while (cond) { __builtin_amdgcn_s_sleep(1); \
    if ((++_sp & 255u) == 0u) { if (xb_ld(&(bar)[XB_TMO])) break; if (_sp > XB_SPIN_CAP) { atomicAdd(&(bar)[XB_TMO], 1u); break; } } } } while (0)

struct XcdBarrier {
    unsigned* bar; unsigned x;
    volatile LAS unsigned* st;
};

__device__ __forceinline__ XcdBarrier xcd_barrier_post(unsigned* bar, volatile LAS unsigned* st) {
    XcdBarrier b; b.bar = bar; b.x = xb_xcc_id(); b.st = st;
    if (threadIdx.x == 0) (void)xb_add(&bar[XB_XCNT(b.x)], 1u);
    return b;
}
__device__ __forceinline__ void xcd_barrier_complete(unsigned* bar, unsigned x, unsigned& nloc, unsigned& nx) {
    const unsigned G = gridDim.x * gridDim.y * gridDim.z;
    unsigned sum, cnt, mine, sp = 0u;
    for (;;) {
        sum = 0u; cnt = 0u; mine = 0u;
#pragma unroll
        for (unsigned j = 0; j < 16; ++j) { const unsigned c = xb_ld(&bar[XB_XCNT(j)]); sum += c; cnt += (c > 0u) ? 1u : 0u; mine = (j == x) ? c : mine; }
        if (sum == G) break;
        __builtin_amdgcn_s_sleep(1);
        if ((++sp & 255u) == 0u) { if (xb_ld(&bar[XB_TMO])) break; if (sp > XB_SPIN_CAP) { atomicAdd(&bar[XB_TMO], 1u); break; } }
    }
    nloc = mine > 0u ? mine : 1u; nx = cnt > 0u ? cnt : 1u;
}

__device__ __forceinline__ void xcd_barrier(const XcdBarrier& b) {
    asm volatile("s_waitcnt vmcnt(0)" ::: "memory");
    __syncthreads();
    if (threadIdx.x == 0) {
        unsigned* bar = b.bar;
        __builtin_amdgcn_s_waitcnt(0);
        unsigned nloc = b.st[0], nx = b.st[1];
        if (nloc == 0u) { xcd_barrier_complete(bar, b.x, nloc, nx); b.st[0] = nloc; b.st[1] = nx; }
        const unsigned old = xb_add(&bar[XB_XSUB(b.x)], 1u);
        const unsigned gen = old / nloc;
        if (old + 1u == (gen + 1u) * nloc) {
            __builtin_amdgcn_fence(__ATOMIC_RELEASE, "agent");
            asm volatile("s_waitcnt vmcnt(0)" ::: "memory");
            const unsigned og = xb_add(&bar[XB_TOP], 1u);
            const unsigned tg = og / nx;
            if (og + 1u == (tg + 1u) * nx) xb_add(&bar[XB_TOPGEN], 1u);
            else XB_SPIN(xb_ld(&bar[XB_TOPGEN]) == tg, bar);
            __builtin_amdgcn_fence(__ATOMIC_ACQUIRE, "agent");
            xb_add(&bar[XB_XGEN(b.x)], 1u);
            asm volatile("s_waitcnt vmcnt(0)" ::: "memory");
        } else {
            XB_SPIN(xb_ld(&bar[XB_XGEN(b.x)]) == gen, bar);
            __builtin_amdgcn_fence(__ATOMIC_ACQUIRE, "agent");
            asm volatile("s_waitcnt vmcnt(0)" ::: "memory");
        }
    }
    __syncthreads();
}


struct Frame {
    LAS unsigned char* lds;
    volatile LAS unsigned* MISC;
    unsigned* ctl;
    int tid, lane, wave, vcu, G;
    const float *x_in, *gains, *w_in, *pool_w, *pool_scale, *conv_w, *rel_bias, *w_branch, *w_gate, *b_gate, *w_out, *w_up, *w_down;
    float* out;
    bf16 *Wcat1, *Wpool, *Wbr, *Wout, *Wup, *Wdown;
    bf16 *Hb, *PROJ, *GATES, *ABUF, *DP, *Y, *MP;
    float *SC, *TMP, *MX;
    unsigned long long* MASK;
};

__device__ __forceinline__ void conv_item(const float* W, int K, int Nsrc, int nblk, bf16* WT, LAS float* scr, int item, int lane) {
    const int kb = item / nblk, nb = item - kb * nblk, k0 = 64 * kb, n0 = 32 * nb;
    const int nl = n0 + (lane & 31); const bool ok = nl < Nsrc;
#pragma unroll 8
    for (int i = 0; i < 32; ++i) { const int kk = 2 * i + (lane >> 5); scr[kk * 33 + (lane & 31)] = ok ? W[(size_t)(k0 + kk) * Nsrc + nl] : 0.f; }
    LDS_WAIT(); asm volatile("" ::: "memory");
    const int c = lane & 7;
#pragma unroll
    for (int j = 0; j < 4; ++j) { const int n = (lane >> 3) + 8 * j; const LAS float* s = scr + (8 * c) * 33 + n;
        v4u o; o.x = pk2(s[0 * 33], s[1 * 33]); o.y = pk2(s[2 * 33], s[3 * 33]); o.z = pk2(s[4 * 33], s[5 * 33]); o.w = pk2(s[6 * 33], s[7 * 33]);
        *(GAS v4u*)(WT + (size_t)(n0 + n) * K + k0 + 8 * c) = o; }
    LDS_WAIT(); asm volatile("" ::: "memory");
}
__device__ __forceinline__ void convert_weights(Frame& F, int l) {
    int lane = F.lane; asm volatile("" : "+v"(lane));
    LAS float* scr = (LAS float*)(F.lds + RING_OFF + F.wave * 16384);
    const int gw = F.vcu * NWAVES + F.wave, NGW = F.G * NWAVES;
    constexpr int I0 = 32 * 216, I1 = 32 * 192, I2 = 4 * 32, I3 = 3 * 1024, I4 = 32 * 64, I5 = 32 * 256, I6 = 128 * 64;
    constexpr int NITEMS = I0 + I1 + I2 + I3 + I4 + I5 + I6;
    for (int it = gw; it < NITEMS; it += NGW) {
        int r = it;
        if (r < I0) { conv_item(F.w_in + (size_t)l * D * INW, D, INW, 216, F.Wcat1, scr, r, lane); continue; } r -= I0;
        if (r < I1) { conv_item(F.w_gate + (size_t)l * D * GW, D, GW, 192, F.Wcat1 + (size_t)INWP * D, scr, r, lane); continue; } r -= I1;
        if (r < I2) { const int g = r >> 5; conv_item(F.pool_w + ((size_t)l * 4 + g) * 65536, 256, 256, 8, F.Wpool + (size_t)g * 65536, scr, r & 31, lane); continue; } r -= I2;
        if (r < I3) { const int n = r >> 10; conv_item(F.w_branch + ((size_t)l * 3 + n) * 1024 * D, 1024, D, 64, F.Wbr + (size_t)n * D * 1024, scr, r & 1023, lane); continue; } r -= I3;
        if (r < I4) { conv_item(F.w_out + (size_t)l * D * D, D, D, 64, F.Wout, scr, r, lane); continue; } r -= I4;
        if (r < I5) { conv_item(F.w_up + (size_t)l * D * FF, D, FF, 256, F.Wup, scr, r, lane); continue; } r -= I5;
        conv_item(F.w_down + (size_t)l * FF * D, FF, D, 64, F.Wdown, scr, r, lane);
    }
}

__device__ __forceinline__ void store_h_row(bf16* orow, const f32x4 (&v)[8], const float* g, float rstd, int lane) {
    GAS v2u* o8 = (GAS v2u*)orow;
#pragma unroll
    for (int j = 0; j < 8; ++j) { const f32x4 gv = ((const f32x4*)g)[lane + 64 * j]; v2u w; w.x = pk2(v[j].x * rstd * gv.x, v[j].y * rstd * gv.y); w.y = pk2(v[j].z * rstd * gv.z, v[j].w * rstd * gv.w); o8[lane + 64 * j] = w; }
}
__device__ __forceinline__ void norm0_phase(Frame& F, const float* x, const float* g, bf16* h) {
    int lane = F.lane; asm volatile("" : "+v"(lane));
    const int gw = F.vcu * NWAVES + F.wave, NGW = F.G * NWAVES;
    for (int row = gw; row < M; row += NGW) {
        f32x4 v[8]; float s = 0.f;
#pragma unroll
        for (int j = 0; j < 8; ++j) { v[j] = ((const f32x4*)(x + (size_t)row * D))[lane + 64 * j]; s += (v[j].x * v[j].x + v[j].y * v[j].y) + (v[j].z * v[j].z + v[j].w * v[j].w); }
        const float rstd = 1.0f / sqrtf(wave_sum(s) * (1.0f / D) + EPS);
        store_h_row(h + (size_t)row * D, v, g, rstd, lane);
    }
}
__device__ __forceinline__ void resnorm_phase(Frame& F, const float* xsrc, float* xdst, const float* mbuf, const float* g_post, const float* g_pre, bf16* h) {
    int lane = F.lane; asm volatile("" : "+v"(lane));
    const int gw = F.vcu * NWAVES + F.wave, NGW = F.G * NWAVES;
    for (int row = gw; row < M; row += NGW) {
        f32x4 mv[8], xv[8]; float s = 0.f;
#pragma unroll
        for (int j = 0; j < 8; ++j) { mv[j] = ((const f32x4*)(mbuf + (size_t)row * D))[lane + 64 * j]; xv[j] = ((const f32x4*)(xsrc + (size_t)row * D))[lane + 64 * j];
            s += (mv[j].x * mv[j].x + mv[j].y * mv[j].y) + (mv[j].z * mv[j].z + mv[j].w * mv[j].w); }
        const float rstd = 1.0f / sqrtf(wave_sum(s) * (1.0f / D) + EPS);
        float s2 = 0.f;
#pragma unroll
        for (int j = 0; j < 8; ++j) { const f32x4 gv = ((const f32x4*)g_post)[lane + 64 * j]; xv[j] = xv[j] + mv[j] * gv * rstd;
            ((f32x4*)(xdst + (size_t)row * D))[lane + 64 * j] = xv[j];
            s2 += (xv[j].x * xv[j].x + xv[j].y * xv[j].y) + (xv[j].z * xv[j].z + xv[j].w * xv[j].w); }
        if (g_pre) { const float rstd2 = 1.0f / sqrtf(wave_sum(s2) * (1.0f / D) + EPS); store_h_row(h + (size_t)row * D, xv, g_pre, rstd2, lane); }
    }
}

__device__ __forceinline__ void poolconv_phase(Frame& F, const float* conv_w_l) {
    int tid = F.tid; asm volatile("" : "+v"(tid));
    const int gt = F.vcu * NTHR + tid, NGT = F.G * NTHR;
    for (int idx = gt; idx < M * 128; idx += NGT) {
        const int row = idx >> 7, c8 = (idx & 127) * 8, t = row & (SEQ - 1);
        {
            const int w = 2 << (c8 >> 8); const int lo = (t + 1 - w) > 0 ? (t + 1 - w) : 0;
            float s[8], u[8];
#pragma unroll
            for (int i = 0; i < 8; ++i) s[i] = 0.f;
            for (int ss = lo; ss <= t; ++ss) { unpack8(*(const v4u*)(F.PROJ + (size_t)(row - t + ss) * INWP + O_UPOOL + c8), u);
#pragma unroll
                for (int i = 0; i < 8; ++i) s[i] += u[i]; }
            const float inv = 1.0f / (float)(t + 1 - lo);
            v4u o; o.x = pk2(s[0] * inv - u[0], s[1] * inv - u[1]); o.y = pk2(s[2] * inv - u[2], s[3] * inv - u[3]); o.z = pk2(s[4] * inv - u[4], s[5] * inv - u[5]); o.w = pk2(s[6] * inv - u[6], s[7] * inv - u[7]);
            *(v4u*)(F.DP + (size_t)row * 1024 + c8) = o;
        }
        {
            float acc[8], a[8], b[8];
#pragma unroll
            for (int i = 0; i < 8; ++i) acc[i] = 0.f;
#pragma unroll
            for (int j = 0; j < 3; ++j) { const int tt = t - 2 + j;
                if (tt >= 0) { const bf16* pr = F.PROJ + (size_t)(row - 2 + j) * INWP; unpack8(*(const v4u*)(pr + O_CG + c8), a); unpack8(*(const v4u*)(pr + O_UCONV + c8), b);
                    const f32x4 w0 = *(const f32x4*)(conv_w_l + j * 1024 + c8), w1 = *(const f32x4*)(conv_w_l + j * 1024 + c8 + 4);
                    acc[0] += w0.x * (a[0] * b[0]); acc[1] += w0.y * (a[1] * b[1]); acc[2] += w0.z * (a[2] * b[2]); acc[3] += w0.w * (a[3] * b[3]);
                    acc[4] += w1.x * (a[4] * b[4]); acc[5] += w1.y * (a[5] * b[5]); acc[6] += w1.z * (a[6] * b[6]); acc[7] += w1.w * (a[7] * b[7]); } }
            unpack8(*(const v4u*)(F.PROJ + (size_t)row * INWP + O_BG + c8), a);
            v4u o; o.x = pk2(a[0] * acc[0], a[1] * acc[1]); o.y = pk2(a[2] * acc[2], a[3] * acc[3]); o.z = pk2(a[4] * acc[4], a[5] * acc[5]); o.w = pk2(a[6] * acc[6], a[7] * acc[7]);
            *(v4u*)(F.Y + (size_t)M * 1024 + (size_t)row * 1024 + c8) = o;
        }
    }
}

__device__ __forceinline__ void scores_phase_scalar(Frame& F) {
    int tid = F.tid; asm volatile("" : "+v"(tid));
    LAS float* qs = (LAS float*)(F.lds + RING_OFF);
    LAS float* wsm = (LAS float*)(F.lds + RING_OFF + 32768);
    for (int unit = blockIdx.x; unit < M / 8; unit += F.G) {
        const int row0 = unit * 8, b = row0 / SEQ, t0 = row0 % SEQ;
        __syncthreads();
        for (int i = tid; i < 8 * 1024; i += NTHR) qs[i] = bf2f(F.PROJ[(size_t)(row0 + (i >> 10)) * INWP + O_QI + (i & 1023)]);
        if (tid < 128) wsm[tid] = bf2f(F.PROJ[(size_t)(row0 + (tid >> 4)) * INWP + O_WI + (tid & 15)]) * 0.25f;
        __syncthreads();
        for (int s = tid; s <= t0 + 7; s += NTHR) {
            float kv[64];
            const bf16* kp = F.PROJ + (size_t)(b * SEQ + s) * INWP + O_KI;
#pragma unroll
            for (int c = 0; c < 8; ++c) { float t8[8]; unpack8(*(const v4u*)(kp + 8 * c), t8);
#pragma unroll
                for (int i = 0; i < 8; ++i) kv[8 * c + i] = t8[i]; }
            for (int r = 0; r < 8; ++r) {
                float tot = 0.f;
                for (int h = 0; h < IH; ++h) {
                    float dot = 0.f; const LAS float* qp = qs + r * 1024 + h * 64;
#pragma unroll
                    for (int d = 0; d < 64; ++d) dot = fmaf(qp[d], kv[d], dot);
                    tot += wsm[r * 16 + h] * fmaxf(dot, 0.f);
                }
                if (s <= t0 + r) F.SC[(size_t)(row0 + r) * SEQ + s] = tot;
            }
        }
    }
    __syncthreads();
}

__device__ __forceinline__ unsigned fkey(float f) { const unsigned u = __builtin_bit_cast(unsigned, f); return (u & 0x80000000u) ? ~u : (u | 0x80000000u); }
__device__ __forceinline__ int wave_isum(int v) {
#pragma unroll
    for (int o = 1; o < 64; o <<= 1) v += __shfl_xor(v, o);
    return v;
}
__device__ __forceinline__ void select_phase(Frame& F) {
    int lane = F.lane; asm volatile("" : "+v"(lane));
    const int gw = F.vcu * NWAVES + F.wave, NGW = F.G * NWAVES;
    for (int row = gw; row < M; row += NGW) {
        const int t = row & (SEQ - 1);
        const float* sr = F.SC + (size_t)row * SEQ;
        unsigned key[32];
#pragma unroll
        for (int j = 0; j < 32; ++j) { const int s = 64 * j + lane; key[j] = (s <= t) ? fkey(sr[s]) : 0u; }
        unsigned long long* mr = F.MASK + (size_t)row * 32;
        if (t + 1 <= TOPK) {
#pragma unroll
            for (int j = 0; j < 32; ++j) { const unsigned long long bm = __ballot(key[j] != 0u); if (lane == 0) mr[j] = bm; }
            continue;
        }
        unsigned T = 0u;
        for (int bit = 31; bit >= 0; --bit) {
            const unsigned cand = T | (1u << bit);
            int c = 0;
#pragma unroll
            for (int j = 0; j < 32; ++j) c += (key[j] >= cand) ? 1 : 0;
            c = wave_isum(c);
            if (c >= TOPK) T = cand;
        }
        int cg = 0;
#pragma unroll
        for (int j = 0; j < 32; ++j) cg += (key[j] > T) ? 1 : 0;
        cg = wave_isum(cg);
        const int need = TOPK - cg;
        int taken = 0;
#pragma unroll
        for (int j = 0; j < 32; ++j) {
            const unsigned long long eq = __ballot(key[j] == T);
            const int rank = taken + __popcll(eq & ((1ull << lane) - 1ull));
            const bool sel = (key[j] > T) || (key[j] == T && rank < need);
            taken += __popcll(eq);
            const unsigned long long bm = __ballot(sel);
            if (lane == 0) mr[j] = bm;
        }
    }
}

__device__ __forceinline__ int t5_bucket(int dist) {
    const int n = dist > 0 ? dist : 0;
    const float nf = (float)(n > 1 ? n : 1);
    int large = 16 + (int)(logf(nf / 16.0f) / 2.0794415416798357f * 16.0f);
    large = large < 31 ? large : 31;
    return n < 16 ? n : large;
}

__device__ __forceinline__ void attn_phase_scalar(Frame& F) {
    int lane = F.lane; asm volatile("" : "+v"(lane));
    const int gw = F.vcu * NWAVES + F.wave, NGW = F.G * NWAVES;
    bf16* YA = F.Y + (size_t)2 * M * 1024;
    for (int item = gw; item < M * NH; item += NGW) {
        const int row = item >> 3, h = item & 7, g = h >> 2, b = row / SEQ, t = row % SEQ;
        const unsigned qw = *(const unsigned*)(F.PROJ + (size_t)row * INWP + O_Q + h * HD + 2 * lane);
        const float q0 = bflo(qw), q1 = bfhi(qw);
        const unsigned long long* mr = F.MASK + (size_t)row * 32;
        float mx = -INFINITY, l = 0.f, o0 = 0.f, o1 = 0.f;
        const float scale = 0.08838834764831845f;
        for (int j = 0; j <= (t >> 6); ++j) {
            unsigned long long w = mr[j];
            while (w) {
                const int bpos = __ffsll((long long)w) - 1; w &= w - 1;
                const int s = 64 * j + bpos;
                if (s > t) continue;
                const bf16* kr = F.PROJ + (size_t)(b * SEQ + s) * INWP;
                const unsigned kw = *(const unsigned*)(kr + O_K + g * HD + 2 * lane), vw = *(const unsigned*)(kr + O_V + g * HD + 2 * lane);
                const float dot = wave_sum(q0 * bflo(kw) + q1 * bfhi(kw));
                const float logit = dot * scale + F.rel_bias[t5_bucket(t - s) * NH + h];
                const float nm = fmaxf(mx, logit);
                const float corr = __expf(mx - nm), p = __expf(logit - nm);
                l = l * corr + p; o0 = o0 * corr + p * bflo(vw); o1 = o1 * corr + p * bfhi(vw);
                mx = nm;
            }
        }
        const float inv = 1.0f / l;
        *(unsigned*)(YA + (size_t)row * 1024 + h * HD + 2 * lane) = pk2(o0 * inv, o1 * inv);
    }
}

struct Args { const float* in[13]; float* out; unsigned char* ws; int ph_lo, ph_hi; };
__global__ void __launch_bounds__(NTHR, 2) mk_fwd(Args args) {
    extern __shared__ __attribute__((aligned(16))) unsigned char lds[];
    Frame F;
    F.lds = (LAS unsigned char*)lds;
    F.MISC = (volatile LAS unsigned*)(F.lds + MISC_OFF);
    F.tid = threadIdx.x; F.lane = F.tid & 63; F.wave = __builtin_amdgcn_readfirstlane(F.tid >> 6);
    F.G = gridDim.x; { const int bx = blockIdx.x; F.vcu = (F.G % 8 == 0) ? (bx % 8) * (F.G / 8) + bx / 8 : bx; }
    unsigned char* ws = args.ws;
    F.ctl = (unsigned*)(ws + WS_CTL);
    F.x_in = args.in[0]; F.gains = args.in[1]; F.w_in = args.in[2]; F.pool_w = args.in[3]; F.pool_scale = args.in[4]; F.conv_w = args.in[5]; F.rel_bias = args.in[6];
    F.w_branch = args.in[7]; F.w_gate = args.in[8]; F.b_gate = args.in[9]; F.w_out = args.in[10]; F.w_up = args.in[11]; F.w_down = args.in[12]; F.out = args.out;
    F.Wcat1 = (bf16*)(ws + WS_WCAT1); F.Wpool = (bf16*)(ws + WS_WPOOL); F.Wbr = (bf16*)(ws + WS_WBR); F.Wout = (bf16*)(ws + WS_WOUT); F.Wup = (bf16*)(ws + WS_WUP); F.Wdown = (bf16*)(ws + WS_WDOWN);
    F.Hb = (bf16*)(ws + WS_H); F.PROJ = (bf16*)(ws + WS_PROJ); F.GATES = (bf16*)(ws + WS_GATES); F.ABUF = (bf16*)(ws + WS_ABUF); F.DP = (bf16*)(ws + WS_DP); F.Y = (bf16*)(ws + WS_Y); F.MP = (bf16*)(ws + WS_MP);
    F.SC = (float*)(ws + WS_SC); F.TMP = (float*)(ws + WS_TMP); F.MX = (float*)(ws + WS_MX); F.MASK = (unsigned long long*)(ws + WS_MASK);
    for (int u = F.tid; u < (LDS_BYTES - LDSCTL_OFF) / 4; u += NTHR) ((LAS unsigned*)(F.lds + LDSCTL_OFF))[u] = 0u;
    __syncthreads();
    XcdBarrier bar; bar.bar = F.ctl + CW_BAR; bar.x = 0; bar.st = nullptr;
    if (!MK_SPLIT) bar = xcd_barrier_post(F.ctl + CW_BAR, F.MISC + 8);
#define GRID_BAR() do { if (!MK_SPLIT) xcd_barrier(bar); } while (0)
    const int lo = args.ph_lo, hi = args.ph_hi;
#define IN(k) (lo <= (k) && (k) < hi)
    LAS unsigned char* ring = F.lds + RING_OFF;

    if (IN(0)) { convert_weights(F, 0); norm0_phase(F, F.x_in, F.gains, F.Hb); GRID_BAR(); }

    for (int l = 0; l < DEPTH; ++l) {
        const int pb = 1 + l * NPH;
        const float* g = F.gains + (size_t)l * 4 * D;
        if (IN(pb + 0)) {
            pg8::Gemm gm{F.Hb, F.Wcat1, D, D, D, 0, 0, 0}; pg8::StaticOrder S; S.init(M, N1, F.G, (int)blockIdx.x);
            pg8::EpiProjGate E{F.PROJ, INWP, F.GATES, GW, F.b_gate + (size_t)l * GW, NPJ};
            pg8::gemm_phase<pg8::EpiProjGate, pg8::StaticOrder, true, true>(ring, gm, S, E);
            GRID_BAR();
        }
        if (IN(pb + 1)) { poolconv_phase(F, F.conv_w + (size_t)l * 3 * 1024); scores_phase_scalar(F); GRID_BAR(); }
        if (IN(pb + 2)) {
            pg8::Gemm gm{F.DP, F.Wpool, 1024, 256, 256, 256, 0, 0}; pg8::StaticOrder S; S.init(M, 1024, F.G, (int)blockIdx.x);
            pg8::EpiBf16<2> E{F.Y, 1024, F.pool_scale + (size_t)l * 1024};
            pg8::gemm_phase<pg8::EpiBf16<2>, pg8::StaticOrder, true, true>(ring, gm, S, E);
            select_phase(F);
            GRID_BAR();
        }
        if (IN(pb + 3)) { attn_phase_scalar(F); GRID_BAR(); }
        if (IN(pb + 4)) {
            pg8::Gemm gm{F.Y, F.Wbr, 1024, 1024, 1024, 0, (long)M * 1024, (long)D * 1024}; pg8::StaticOrder S; S.init(M, D, F.G, (int)blockIdx.x, 3);
            pg8::EpiBranch E{F.GATES, GW, D, F.TMP, F.MP, D, 3};
            pg8::gemm_phase<pg8::EpiBranch, pg8::StaticOrder, true, true>(ring, gm, S, E);
            GRID_BAR();
        }
        if (IN(pb + 5)) {
            pg8::Gemm gm{F.MP, F.Wout, D, D, D, 0, 0, 0}; pg8::StaticOrder S; S.init(M, D, F.G, (int)blockIdx.x);
            pg8::EpiF32 E{F.MX, D};
            pg8::gemm_phase<pg8::EpiF32, pg8::StaticOrder, true, true>(ring, gm, S, E);
            GRID_BAR();
        }
        if (IN(pb + 6)) { resnorm_phase(F, l == 0 ? F.x_in : F.out, F.out, F.MX, g + D, g + 2 * D, F.Hb); GRID_BAR(); }
        if (IN(pb + 7)) {
            pg8::Gemm gm{F.Hb, F.Wup, D, D, D, 0, 0, 0}; pg8::StaticOrder S; S.init(M, FF, F.G, (int)blockIdx.x);
            pg8::EpiBf16<1> E{F.ABUF, FF, nullptr};
            pg8::gemm_phase<pg8::EpiBf16<1>, pg8::StaticOrder, true, true>(ring, gm, S, E);
            GRID_BAR();
        }
        if (IN(pb + 8)) {
            pg8::Gemm gm{F.ABUF, F.Wdown, FF, FF, FF, 0, 0, 0}; pg8::StaticOrder S; S.init(M, D, F.G, (int)blockIdx.x);
            pg8::EpiF32 E{F.MX, D};
            pg8::gemm_phase<pg8::EpiF32, pg8::StaticOrder, true, true>(ring, gm, S, E);
            GRID_BAR();
        }
        if (IN(pb + 9)) {
            if (l + 1 < DEPTH) { convert_weights(F, l + 1); resnorm_phase(F, F.out, F.out, F.MX, g + 3 * D, g + 4 * D, F.Hb); GRID_BAR(); }
            else resnorm_phase(F, F.out, F.out, F.MX, g + 3 * D, nullptr, nullptr);
        }
    }
#undef IN
#undef GRID_BAR
}

extern "C" void kernel_launch(void* const* d_in, const int* in_sizes, int n_in, void* d_out, int out_size, void* d_ws, size_t ws_size, hipStream_t stream) {
    static int grid = 0;
    if (grid == 0) {
        if (n_in != 13 || out_size != M * D || ws_size < WS_END) { fprintf(stderr, "kernel_launch: unexpected shapes (n_in %d out %d ws %zu need %zu); nothing launched\n", n_in, out_size, ws_size, (size_t)WS_END); grid = -1; return; }
        int dev = 0, cus = 0, per_cu = 0;
        if (hipGetDevice(&dev) != hipSuccess || hipDeviceGetAttribute(&cus, hipDeviceAttributeMultiprocessorCount, dev) != hipSuccess) { grid = -1; return; }
        if (hipFuncSetAttribute((const void*)mk_fwd, hipFuncAttributeMaxDynamicSharedMemorySize, LDS_BYTES) != hipSuccess) { fprintf(stderr, "kernel_launch: hipFuncSetAttribute failed\n"); grid = -1; return; }
        if (hipOccupancyMaxActiveBlocksPerMultiprocessor(&per_cu, (const void*)mk_fwd, NTHR, LDS_BYTES) != hipSuccess || per_cu < 1) { fprintf(stderr, "kernel_launch: occupancy query says %d\n", per_cu); }
        (void)hipGetLastError();
        grid = cus;
    }
    if (grid < 0) return;
    if (hipMemsetAsync((char*)d_ws + WS_CTL, 0, CTL_ZERO_BYTES, stream) != hipSuccess) return;
    Args a{};
    for (int i = 0; i < 13; ++i) a.in[i] = (const float*)d_in[i];
    a.out = (float*)d_out; a.ws = (unsigned char*)d_ws;
#if MK_SPLIT
    for (int p = 0; p < 1 + DEPTH * NPH; ++p) { a.ph_lo = p; a.ph_hi = p + 1; hipLaunchKernelGGL(mk_fwd, dim3(grid), dim3(NTHR), LDS_BYTES, stream, a); }
#else
    a.ph_lo = 0; a.ph_hi = 1 << 20;
    hipLaunchKernelGGL(mk_fwd, dim3(grid), dim3(NTHR), LDS_BYTES, stream, a);
#endif
}
```

```cpp
#include <hip/hip_runtime.h>
#include <cstdio>
#include <cstdint>

#ifndef MK_SPLIT
#define MK_SPLIT 0
#endif

namespace pg8 {
#define PG8_LAS __attribute__((address_space(3)))
typedef unsigned short bf16_t;
typedef short bf16x8 __attribute__((ext_vector_type(8)));
typedef float f32x4 __attribute__((ext_vector_type(4)));
typedef float f32x2 __attribute__((ext_vector_type(2)));
typedef unsigned u32x4 __attribute__((ext_vector_type(4)));
constexpr int BM = 256, BK = 64, HALF = 128, HTB = HALF * BK * 2  , STAGE_BYTES = 8 * HTB, NXCD = 8, WGM = 8;

__host__ __device__ __forceinline__ int lds_byte(int r, int c) { const int st = (r >> 4) * 2 + (c >> 5), rr = r & 15, cc = c & 31, ob = rr * 64 + cc * 2; return st * 1024 + (ob ^ (((ob >> 9) & 1) << 5)); }
__host__ __device__ __forceinline__ void stage_rc(int b, int& R, int& C) { const int st = b / 1024, sb = b % 1024, swz = sb ^ (((sb >> 9) & 1) << 5); R = (st >> 1) * 16 + swz / 64; C = (st & 1) * 32 + (swz % 64) / 2; }
__host__ __device__ __forceinline__ int perm32(int rho) { const int n = rho >> 4, i = rho & 15; return 8 * (i >> 2) + 4 * n + (i & 3); }

struct Unit { int pm, pn, sub; };
struct Gemm {
    const bf16_t* A; const bf16_t* Bt; int lda, ldb, K; long a_pn, a_sub, b_sub;
    __device__ __forceinline__ const char* pa(const Unit& u) const { return (const char*)(A + ((size_t)u.pm * BM * lda + (size_t)u.pn * a_pn + (size_t)u.sub * a_sub)); }
    __device__ __forceinline__ const char* pb(const Unit& u) const { return (const char*)(Bt + ((size_t)u.pn * BM * ldb + (size_t)u.sub * b_sub)); }
};

struct StaticOrder {
    int nM, nN, nwg, G, c, subs;
    __host__ __device__ void init(int M, int N, int G_, int c_, int subs_ = 1) { nM = M / BM; nN = N / BM; nwg = nM * nN; G = G_; c = c_; subs = subs_; }
    __host__ __device__ bool next(int i, Unit& u) const {
        const int ti = i / subs;
        const long L = (long)ti * G + c; if (L >= nwg) return false;
        int wgid = (int)L; { const int q = nwg / NXCD, r = nwg % NXCD, xcd = wgid % NXCD, off = wgid / NXCD; wgid = (xcd < r ? xcd * (q + 1) : r * (q + 1) + (xcd - r) * q) + off; }
        const int nig = WGM * nN, gid = wgid / nig, fm = gid * WGM, gsz = (nM - fm) < WGM ? (nM - fm) : WGM;
        u.pm = fm + ((wgid % nig) % gsz); u.pn = (wgid % nig) / gsz; u.sub = i - ti * subs; return true;
    }
    __device__ __forceinline__ void a_ready(const Unit&) const {}
    __device__ __forceinline__ void done(const Unit&) const {}
};

typedef __bf16 bf16x2_t __attribute__((ext_vector_type(2)));
__device__ __forceinline__ unsigned cvt_pk_bf16(float lo, float hi) { const f32x2 v = {lo, hi}; return __builtin_bit_cast(unsigned, __builtin_convertvector(v, bf16x2_t)); }
__device__ __forceinline__ float bflo(unsigned w) { return __builtin_bit_cast(float, w << 16); }
__device__ __forceinline__ float bfhi(unsigned w) { return __builtin_bit_cast(float, w & 0xffff0000u); }
__device__ __forceinline__ u32x4 pack8(const f32x4& v0, const f32x4& v1) { u32x4 w; w.x = cvt_pk_bf16(v0[0], v0[1]); w.y = cvt_pk_bf16(v0[2], v0[3]); w.z = cvt_pk_bf16(v1[0], v1[1]); w.w = cvt_pk_bf16(v1[2], v1[3]); return w; }

struct EpiF32 {
    static constexpr bool PERM = false, AFTER_DRAIN = false;
    float* C; int ldc;
    __device__ __forceinline__ void operator()(const f32x4 (&acc)[2][2][4][2], const Unit& u, int wr, int wc, int fr_, int fq_) const {
        int fr = fr_, fq = fq_; asm volatile("" : "+v"(fr), "+v"(fq));
        const int row0 = u.pm * BM + wr * 64 + fr, col0 = u.pn * BM + wc * 32 + 4 * fq;
#pragma unroll
        for (int ai = 0; ai < 2; ++ai)
#pragma unroll
            for (int m = 0; m < 4; ++m) { float* rowp = C + (size_t)(row0 + ai * HALF + m * 16) * ldc + col0;
#pragma unroll
                for (int bj = 0; bj < 2; ++bj)
#pragma unroll
                    for (int n = 0; n < 2; ++n) *(f32x4*)(rowp + bj * HALF + n * 16) = acc[ai][bj][m][n]; }
    }
};
template <int ACT> struct EpiBf16 {
    static constexpr bool PERM = true, AFTER_DRAIN = false;
    bf16_t* O; int ldc; const float* vec;
    __device__ __forceinline__ void operator()(const f32x4 (&acc)[2][2][4][2], const Unit& u, int wr, int wc, int fr_, int fq_) const {
        int fr = fr_, fq = fq_; asm volatile("" : "+v"(fr), "+v"(fq));
        const int row0 = u.pm * BM + wr * 64 + fr, col0 = u.pn * BM + wc * 32 + 8 * fq;
        f32x4 sv[2][2];
        if (ACT == 2) {
#pragma unroll
            for (int bj = 0; bj < 2; ++bj)
#pragma unroll
                for (int n = 0; n < 2; ++n) sv[bj][n] = *(const f32x4*)(vec + col0 + bj * HALF + 4 * n);
        }
#pragma unroll
        for (int ai = 0; ai < 2; ++ai)
#pragma unroll
            for (int m = 0; m < 4; ++m) { bf16_t* rowp = O + (size_t)(row0 + ai * HALF + m * 16) * ldc + col0;
#pragma unroll
                for (int bj = 0; bj < 2; ++bj) { f32x4 v0 = acc[ai][bj][m][0], v1 = acc[ai][bj][m][1];
                    if (ACT == 1) {
#pragma unroll
                        for (int j = 0; j < 4; ++j) { const float a = fmaxf(v0[j], 0.f), b = fmaxf(v1[j], 0.f); v0[j] = a * a; v1[j] = b * b; } }
                    if (ACT == 2) { v0 = v0 * sv[bj][0]; v1 = v1 * sv[bj][1]; }
                    *(u32x4*)(rowp + bj * HALF) = pack8(v0, v1); } }
    }
};
struct EpiProjGate {
    static constexpr bool PERM = true, AFTER_DRAIN = false;
    bf16_t* P; int ldp; bf16_t* Gt; int ldg; const float* bias; int npj;
    __device__ __forceinline__ void operator()(const f32x4 (&acc)[2][2][4][2], const Unit& u, int wr, int wc, int fr_, int fq_) const {
        int fr = fr_, fq = fq_; asm volatile("" : "+v"(fr), "+v"(fq));
        const int row0 = u.pm * BM + wr * 64 + fr;
        if (u.pn < npj) {
            const int col0 = u.pn * BM + wc * 32 + 8 * fq;
#pragma unroll
            for (int ai = 0; ai < 2; ++ai)
#pragma unroll
                for (int m = 0; m < 4; ++m) { bf16_t* rowp = P + (size_t)(row0 + ai * HALF + m * 16) * ldp + col0;
#pragma unroll
                    for (int bj = 0; bj < 2; ++bj) *(u32x4*)(rowp + bj * HALF) = pack8(acc[ai][bj][m][0], acc[ai][bj][m][1]); }
        } else {
            const int col0 = (u.pn - npj) * BM + wc * 32 + 8 * fq;
            f32x4 bv[2][2];
#pragma unroll
            for (int bj = 0; bj < 2; ++bj)
#pragma unroll
                for (int n = 0; n < 2; ++n) bv[bj][n] = *(const f32x4*)(bias + col0 + bj * HALF + 4 * n);
#pragma unroll
            for (int ai = 0; ai < 2; ++ai)
#pragma unroll
                for (int m = 0; m < 4; ++m) { bf16_t* rowp = Gt + (size_t)(row0 + ai * HALF + m * 16) * ldg + col0;
#pragma unroll
                    for (int bj = 0; bj < 2; ++bj) { f32x4 v0 = acc[ai][bj][m][0] + bv[bj][0], v1 = acc[ai][bj][m][1] + bv[bj][1];
#pragma unroll
                        for (int j = 0; j < 4; ++j) { v0[j] = __builtin_amdgcn_rcpf(1.0f + __expf(-v0[j])); v1[j] = __builtin_amdgcn_rcpf(1.0f + __expf(-v1[j])); }
                        *(u32x4*)(rowp + bj * HALF) = pack8(v0, v1); } }
        }
    }
};
struct EpiBranch {
    static constexpr bool PERM = true, AFTER_DRAIN = false;
    const bf16_t* Gt; int ldg; int gsub; float* tmp; bf16_t* O; int ldc; int nsub;
    __device__ __forceinline__ void operator()(const f32x4 (&acc)[2][2][4][2], const Unit& u, int wr, int wc, int fr_, int fq_) const {
        int fr = fr_, fq = fq_; asm volatile("" : "+v"(fr), "+v"(fq));
        const int row0 = u.pm * BM + wr * 64 + fr, col0 = u.pn * BM + wc * 32 + 8 * fq;
#pragma unroll
        for (int ai = 0; ai < 2; ++ai)
#pragma unroll
            for (int m = 0; m < 4; ++m) { const size_t r = (size_t)(row0 + ai * HALF + m * 16);
#pragma unroll
                for (int bj = 0; bj < 2; ++bj) { const int c = col0 + bj * HALF;
                    const u32x4 gw = *(const u32x4*)(Gt + r * ldg + (size_t)u.sub * gsub + c);
                    f32x4 v0 = acc[ai][bj][m][0], v1 = acc[ai][bj][m][1];
                    v0[0] *= bflo(gw.x); v0[1] *= bfhi(gw.x); v0[2] *= bflo(gw.y); v0[3] *= bfhi(gw.y);
                    v1[0] *= bflo(gw.z); v1[1] *= bfhi(gw.z); v1[2] *= bflo(gw.w); v1[3] *= bfhi(gw.w);
                    float* tp = tmp + r * ldc + c;
                    if (u.sub > 0) { v0 = v0 + *(const f32x4*)tp; v1 = v1 + *(const f32x4*)(tp + 4); }
                    if (u.sub < nsub - 1) { *(f32x4*)tp = v0; *(f32x4*)(tp + 4) = v1; }
                    else *(u32x4*)(O + r * ldc + c) = pack8(v0, v1); } }
    }
};

template <class Epi, class Sched, bool ALIGN_EPI = false, bool SP2 = false>
__device__ __forceinline__ void gemm_phase(PG8_LAS unsigned char* lds, const Gemm g_in, const Sched& S, const Epi& E) {
    Gemm g = g_in; asm volatile("" : "+s"(g.A), "+s"(g.Bt));
    int tid_l = threadIdx.x; asm volatile("" : "+v"(tid_l));
    const int tid = tid_l, wid = __builtin_amdgcn_readfirstlane(tid >> 6), lane = tid & 63, wr = wid >> 2, wc = wid & 3, fr = lane & 15, fq = lane >> 4;
    const int K = g.K, nt = K / BK;
    unsigned voffA[2], voffB[2];
#pragma unroll
    for (int i = 0; i < 2; ++i) { int R, C; stage_rc(tid * 16 + i * 8192, R, C); const int Rb = Epi::PERM ? ((R & ~31) + perm32(R & 31)) : R;
        voffA[i] = (unsigned)(R * g.lda + C) * 2u; voffB[i] = (unsigned)(Rb * g.ldb + C) * 2u; }
    const size_t kstep = (size_t)(BK * 2);
    const size_t hstepA = (size_t)HALF * g.lda * 2, hstepB = (size_t)HALF * g.ldb * 2;
    const unsigned ldsw = (unsigned)wid * 1024u;
    const int aoff = lds_byte(wr * 64 + fr, fq * 8), boff = lds_byte(wc * 32 + fr, fq * 8);
#define PG8_SA(b, h) (((b) * 2 + (h)) * HTB)
#define PG8_SB(b, h) ((4 + (b) * 2 + (h)) * HTB)
#define PG8_STAGE(bufoff, gbase, voff) do { _Pragma("unroll") for (int _i = 0; _i < 2; ++_i) \
        __builtin_amdgcn_global_load_lds((const unsigned*)((const char*)(gbase) + (voff)[_i]), (PG8_LAS unsigned*)(lds + (bufoff) + ldsw + _i * 8192), 16, 0, 0); } while (0)
#define PG8_LDA(dst, b, h) do { _Pragma("unroll") for (int m = 0; m < 4; ++m) _Pragma("unroll") for (int k = 0; k < 2; ++k) dst[m][k] = *(const PG8_LAS bf16x8*)(lds + PG8_SA(b, h) + aoff + m * 2048 + k * 1024); } while (0)
#define PG8_LDB(dst, b, h) do { _Pragma("unroll") for (int n = 0; n < 2; ++n) _Pragma("unroll") for (int k = 0; k < 2; ++k) dst[n][k] = *(const PG8_LAS bf16x8*)(lds + PG8_SB(b, h) + boff + n * 2048 + k * 1024); } while (0)
#define PG8_MMA(ai, bj, At, Bt) do { __builtin_amdgcn_s_setprio(1); _Pragma("unroll") for (int m = 0; m < 4; ++m) _Pragma("unroll") for (int n = 0; n < 2; ++n) _Pragma("unroll") for (int k = 0; k < 2; ++k) \
        acc[ai][bj][m][n] = __builtin_amdgcn_mfma_f32_16x16x32_bf16(Bt[n][k], At[m][k], acc[ai][bj][m][n], 0, 0, 0); __builtin_amdgcn_s_setprio(0); } while (0)
#define PG8_WAIT_V(n) asm volatile("s_waitcnt vmcnt(" #n ")" ::: "memory")
#define PG8_WAIT_L(n) asm volatile("s_waitcnt lgkmcnt(" #n ")" ::: "memory")
#define PG8_BAR __builtin_amdgcn_s_barrier()
#define PG8_SCHED __builtin_amdgcn_sched_barrier(0)
    Unit cur, nxt; int ui = 0;
    if (!S.next(0, cur)) return;
    f32x4 acc[2][2][4][2];
#pragma unroll
    for (int a = 0; a < 2; ++a)
#pragma unroll
        for (int b = 0; b < 2; ++b)
#pragma unroll
            for (int m = 0; m < 4; ++m)
#pragma unroll
                for (int n = 0; n < 2; ++n) acc[a][b][m][n] = (f32x4){0.f, 0.f, 0.f, 0.f};
    bf16x8 At[4][2], B0[2][2], B1[2][2];
    const char* cA = g.pa(cur); const char* cB = g.pb(cur);
    S.a_ready(cur);
    if constexpr (SP2) {
        PG8_STAGE(PG8_SB(0, 0), cB, voffB); PG8_STAGE(PG8_SB(0, 1), cB + hstepB, voffB); PG8_STAGE(PG8_SA(0, 0), cA, voffA); PG8_STAGE(PG8_SA(0, 1), cA + hstepA, voffA);
        if (wr == 1) PG8_BAR;
        PG8_WAIT_V(2); PG8_BAR;
        PG8_STAGE(PG8_SB(1, 0), cB + kstep, voffB); PG8_STAGE(PG8_SA(1, 0), cA + kstep, voffA); PG8_STAGE(PG8_SB(1, 1), cB + hstepB + kstep, voffB);
        PG8_WAIT_V(6); PG8_BAR;
    } else {
        PG8_STAGE(PG8_SB(0, 0), cB, voffB); PG8_STAGE(PG8_SA(0, 0), cA, voffA); PG8_STAGE(PG8_SB(0, 1), cB + hstepB, voffB); PG8_STAGE(PG8_SA(0, 1), cA + hstepA, voffA);
        if (wr == 1) PG8_BAR;
        PG8_WAIT_V(4); PG8_BAR;
        PG8_STAGE(PG8_SB(1, 0), cB + kstep, voffB); PG8_STAGE(PG8_SA(1, 0), cA + kstep, voffA); PG8_STAGE(PG8_SB(1, 1), cB + hstepB + kstep, voffB);
        PG8_WAIT_V(6); PG8_BAR;
    }
    for (;;) {
        const bool has_next = S.next(ui + 1, nxt);
        const char* nA = has_next ? g.pa(nxt) : cA; const char* nB = has_next ? g.pb(nxt) : cB;
#pragma unroll 1
        for (int t = 0; t < nt; t += 2) {
            const bool last = (t == nt - 2);
            const char* a1 = cA + (size_t)(t + 1) * kstep;
            const char* a2 = last ? nA : cA + (size_t)(t + 2) * kstep; const char* b2 = last ? nB : cB + (size_t)(t + 2) * kstep;
            const char* a3 = a2 + kstep; const char* b3 = b2 + kstep;
            if (last && has_next) S.a_ready(nxt);
            if constexpr (SP2) {
            PG8_LDB(B0, 0, 0); PG8_LDB(B1, 0, 1); PG8_SCHED; PG8_LDA(At, 0, 0); PG8_STAGE(PG8_SA(1, 1), a1 + hstepA, voffA);
            PG8_WAIT_V(8); PG8_WAIT_L(0); PG8_BAR; PG8_MMA(0, 0, At, B0); PG8_MMA(0, 1, At, B1); PG8_BAR; PG8_SCHED;
            PG8_LDA(At, 0, 1); PG8_STAGE(PG8_SB(0, 0), b2, voffB); PG8_STAGE(PG8_SB(0, 1), b2 + hstepB, voffB); PG8_STAGE(PG8_SA(0, 0), a2, voffA);
            PG8_WAIT_V(8); PG8_WAIT_L(0); PG8_BAR; PG8_MMA(1, 0, At, B0); PG8_MMA(1, 1, At, B1); PG8_BAR; PG8_SCHED;
            PG8_LDB(B0, 1, 0); PG8_LDB(B1, 1, 1); PG8_SCHED; PG8_LDA(At, 1, 0); PG8_STAGE(PG8_SA(0, 1), a2 + hstepA, voffA);
            PG8_WAIT_V(8); PG8_WAIT_L(0); PG8_BAR; PG8_MMA(0, 0, At, B0); PG8_MMA(0, 1, At, B1); PG8_BAR; PG8_SCHED;
            PG8_LDA(At, 1, 1); PG8_STAGE(PG8_SB(1, 0), b3, voffB); PG8_STAGE(PG8_SB(1, 1), b3 + hstepB, voffB); PG8_STAGE(PG8_SA(1, 0), a3, voffA);
            PG8_WAIT_V(8); PG8_WAIT_L(0); PG8_BAR; PG8_MMA(1, 0, At, B0); PG8_MMA(1, 1, At, B1); PG8_BAR; PG8_SCHED;
            } else {
            PG8_LDB(B0, 0, 0); PG8_SCHED; PG8_LDA(At, 0, 0); PG8_STAGE(PG8_SA(1, 1), a1 + hstepA, voffA);
            PG8_WAIT_L(8); PG8_BAR; PG8_WAIT_L(0); PG8_MMA(0, 0, At, B0); PG8_BAR; PG8_SCHED;
            PG8_LDB(B1, 0, 1); PG8_STAGE(PG8_SB(0, 0), b2, voffB);
            PG8_BAR; PG8_WAIT_L(0); PG8_MMA(0, 1, At, B1); PG8_BAR;
            PG8_LDA(At, 0, 1); PG8_STAGE(PG8_SA(0, 0), a2, voffA);
            PG8_BAR; PG8_WAIT_L(0); PG8_MMA(1, 0, At, B0); PG8_BAR; PG8_SCHED;
            PG8_STAGE(PG8_SB(0, 1), b2 + hstepB, voffB);
            PG8_WAIT_V(6); PG8_BAR; PG8_MMA(1, 1, At, B1); PG8_BAR;
            PG8_LDB(B0, 1, 0); PG8_SCHED; PG8_LDA(At, 1, 0); PG8_STAGE(PG8_SA(0, 1), a2 + hstepA, voffA);
            PG8_WAIT_L(8); PG8_BAR; PG8_WAIT_L(0); PG8_MMA(0, 0, At, B0); PG8_BAR; PG8_SCHED;
            PG8_LDB(B1, 1, 1); PG8_STAGE(PG8_SB(1, 0), b3, voffB);
            PG8_BAR; PG8_WAIT_L(0); PG8_MMA(0, 1, At, B1); PG8_BAR;
            PG8_LDA(At, 1, 1); PG8_STAGE(PG8_SA(1, 0), a3, voffA);
            PG8_BAR; PG8_WAIT_L(0); PG8_MMA(1, 0, At, B0); PG8_BAR; PG8_SCHED;
            PG8_STAGE(PG8_SB(1, 1), b3 + hstepB, voffB);
            PG8_WAIT_V(6); PG8_BAR; PG8_MMA(1, 1, At, B1); PG8_BAR;
            }
        }
        if constexpr (ALIGN_EPI) { if (wr == 0) PG8_BAR; }
        if constexpr (!Epi::AFTER_DRAIN) { E(acc, cur, wr, wc, fr, fq); S.done(cur); }
        if (!has_next) break;
#pragma unroll
        for (int a = 0; a < 2; ++a)
#pragma unroll
            for (int b = 0; b < 2; ++b)
#pragma unroll
                for (int m = 0; m < 4; ++m)
#pragma unroll
                    for (int n = 0; n < 2; ++n) acc[a][b][m][n] = (f32x4){0.f, 0.f, 0.f, 0.f};
        cur = nxt; cA = nA; cB = nB; ++ui;
        if constexpr (ALIGN_EPI) { if (wr == 1) PG8_BAR; }
    }
    PG8_WAIT_V(0);
    if constexpr (!ALIGN_EPI) { if (wr == 0) PG8_BAR; }
    PG8_BAR;
    if constexpr (Epi::AFTER_DRAIN) { E.fused(acc, cur, wr, wc, fr, fq, lds, wid, lane); S.done(cur); }
#undef PG8_SA
#undef PG8_SB
#undef PG8_STAGE
#undef PG8_LDA
#undef PG8_LDB
#undef PG8_MMA
#undef PG8_WAIT_V
#undef PG8_WAIT_L
#undef PG8_BAR
#undef PG8_SCHED
}

}
#ifndef USE_MFMA_SC
#define USE_MFMA_SC 1
#endif
#ifndef USE_MFMA_AT
#define USE_MFMA_AT 1
#endif

constexpr int NWAVES = 8, NTHR = NWAVES * 64;
constexpr int D = 2048, BATCH = 4, SEQ = 2048, DEPTH = 4, M = BATCH * SEQ;
constexpr int INW = 6736, INWP = 6912, GW = 3 * D, N1 = INWP + GW, FF = 8192, NPJ = INWP / 256;
constexpr int O_UPOOL = 0, O_UCONV = 1024, O_CG = 2048, O_BG = 3072, O_Q = 4096, O_K = 5120, O_V = 5376, O_QI = 5632, O_KI = 6656, O_WI = 6720;
constexpr int NH = 8, HD = 128, IH = 16, IDIM = 64, TOPK = 256;
constexpr float EPS = 1e-6f;
constexpr int NPH = 10;

constexpr size_t MiB = 1u << 20;
constexpr size_t WS_CTL = 0, CTL_ZERO_BYTES = 1 * MiB;
constexpr size_t WS_WCAT1 = 1 * MiB;
constexpr size_t WS_WPOOL = 52 * MiB;
constexpr size_t WS_WBR = 53 * MiB;
constexpr size_t WS_WOUT = 65 * MiB;
constexpr size_t WS_WUP = 73 * MiB;
constexpr size_t WS_WDOWN = 105 * MiB;
constexpr size_t WS_H = 137 * MiB;
constexpr size_t WS_PROJ = 169 * MiB;
constexpr size_t WS_GATES = 277 * MiB;
constexpr size_t WS_ABUF = WS_PROJ;
constexpr size_t WS_DP = 373 * MiB;
constexpr size_t WS_Y = 389 * MiB;
constexpr size_t WS_SC = 437 * MiB;
constexpr size_t WS_MASK = 501 * MiB;
constexpr size_t WS_TMP = 503 * MiB;
constexpr size_t WS_MP = 567 * MiB;
constexpr size_t WS_MX = 599 * MiB;
constexpr size_t WS_END = 663 * MiB;
static_assert(WS_WCAT1 + (size_t)N1 * D * 2 <= WS_WPOOL && WS_PROJ + (size_t)M * INWP * 2 <= WS_GATES && WS_GATES + (size_t)M * GW * 2 <= WS_DP && WS_ABUF + (size_t)M * FF * 2 <= WS_DP, "ws map");
constexpr int CW_BAR = 4096;

constexpr int RING_OFF = 0, RING_BYTES = 131072;
constexpr int LDSCTL_OFF = RING_BYTES, MISC_OFF = LDSCTL_OFF + 320;
constexpr int LDS_BYTES = 147456;

#define GAS __attribute__((address_space(1)))
#define LAS __attribute__((address_space(3)))
typedef unsigned short bf16;
typedef unsigned v4u __attribute__((ext_vector_type(4)));
typedef unsigned v2u __attribute__((ext_vector_type(2)));
typedef float f32x4 __attribute__((ext_vector_type(4)));
#define LDS_WAIT() asm volatile("s_waitcnt lgkmcnt(0)" ::: "memory")
#define VM_WAIT() asm volatile("s_waitcnt vmcnt(0)" ::: "memory")
__device__ __forceinline__ unsigned f2bf(float f) { unsigned u = __builtin_bit_cast(unsigned, f); return (u + 0x7fffu + ((u >> 16) & 1u)) >> 16; }
__device__ __forceinline__ unsigned pk2(float lo, float hi) { return f2bf(lo) | (f2bf(hi) << 16); }
__device__ __forceinline__ float bflo(unsigned w) { return __builtin_bit_cast(float, w << 16); }
__device__ __forceinline__ float bfhi(unsigned w) { return __builtin_bit_cast(float, w & 0xffff0000u); }
__device__ __forceinline__ float bf2f(bf16 b) { return __builtin_bit_cast(float, (unsigned)b << 16); }
__device__ __forceinline__ void unpack8(const v4u w, float (&f)[8]) { f[0] = bflo(w.x); f[1] = bfhi(w.x); f[2] = bflo(w.y); f[3] = bfhi(w.y); f[4] = bflo(w.z); f[5] = bfhi(w.z); f[6] = bflo(w.w); f[7] = bfhi(w.w); }
__device__ __forceinline__ float wave_sum(float v) {
#pragma unroll
    for (int o = 1; o < 64; o <<= 1) v += __shfl_xor(v, o);
    return v;
}

#define XB_TMO      128
#define XB_XCNT(j)  (256  + 64 * (j))
#define XB_XSUB(j)  (1280 + 64 * (j))
#define XB_XGEN(j)  (2304 + 64 * (j))
#define XB_TOP      3328
#define XB_TOPGEN   3392
#define XCD_BAR_WORDS 3456
#define XB_SPIN_CAP (1u << 18)

__device__ __forceinline__ unsigned xb_ld(unsigned* p)              { return __hip_atomic_load(p, __ATOMIC_RELAXED, __HIP_MEMORY_SCOPE_AGENT); }
__device__ __forceinline__ unsigned xb_add(unsigned* p, unsigned v) { return __hip_atomic_fetch_add(p, v, __ATOMIC_RELAXED, __HIP_MEMORY_SCOPE_AGENT); }
__device__ __forceinline__ unsigned xb_xcc_id() { return (unsigned)__builtin_amdgcn_s_getreg((3 << 11) | 20) & 0xFu; }
#define XB_SPIN(cond, bar) do { unsigned _sp = 0; while (cond) { __builtin_amdgcn_s_sleep(1); \
    if ((++_sp & 255u) == 0u) { if (xb_ld(&(bar)[XB_TMO])) break; if (_sp > XB_SPIN_CAP) { atomicAdd(&(bar)[XB_TMO], 1u); break; } } } } while (0)

struct XcdBarrier {
    unsigned* bar; unsigned x;
    volatile LAS unsigned* st;
};

__device__ __forceinline__ XcdBarrier xcd_barrier_post(unsigned* bar, volatile LAS unsigned* st) {
    XcdBarrier b; b.bar = bar; b.x = xb_xcc_id(); b.st = st;
    if (threadIdx.x == 0) (void)xb_add(&bar[XB_XCNT(b.x)], 1u);
    return b;
}
__device__ __forceinline__ void xcd_barrier_complete(unsigned* bar, unsigned x, unsigned& nloc, unsigned& nx) {
    const unsigned G = gridDim.x * gridDim.y * gridDim.z;
    unsigned sum, cnt, mine, sp = 0u;
    for (;;) {
        sum = 0u; cnt = 0u; mine = 0u;
#pragma unroll
        for (unsigned j = 0; j < 16; ++j) { const unsigned c = xb_ld(&bar[XB_XCNT(j)]); sum += c; cnt += (c > 0u) ? 1u : 0u; mine = (j == x) ? c : mine; }
        if (sum == G) break;
        __builtin_amdgcn_s_sleep(1);
        if ((++sp & 255u) == 0u) { if (xb_ld(&bar[XB_TMO])) break; if (sp > XB_SPIN_CAP) { atomicAdd(&bar[XB_TMO], 1u); break; } }
    }
    nloc = mine > 0u ? mine : 1u; nx = cnt > 0u ? cnt : 1u;
}

__device__ __forceinline__ void xcd_barrier(const XcdBarrier& b) {
    asm volatile("s_waitcnt vmcnt(0)" ::: "memory");
    __syncthreads();
    if (threadIdx.x == 0) {
        unsigned* bar = b.bar;
        __builtin_amdgcn_s_waitcnt(0);
        unsigned nloc = b.st[0], nx = b.st[1];
        if (nloc == 0u) { xcd_barrier_complete(bar, b.x, nloc, nx); b.st[0] = nloc; b.st[1] = nx; }
        const unsigned old = xb_add(&bar[XB_XSUB(b.x)], 1u);
        const unsigned gen = old / nloc;
        if (old + 1u == (gen + 1u) * nloc) {
            __builtin_amdgcn_fence(__ATOMIC_RELEASE, "agent");
            asm volatile("s_waitcnt vmcnt(0)" ::: "memory");
            const unsigned og = xb_add(&bar[XB_TOP], 1u);
            const unsigned tg = og / nx;
            if (og + 1u == (tg + 1u) * nx) xb_add(&bar[XB_TOPGEN], 1u);
            else XB_SPIN(xb_ld(&bar[XB_TOPGEN]) == tg, bar);
            __builtin_amdgcn_fence(__ATOMIC_ACQUIRE, "agent");
            xb_add(&bar[XB_XGEN(b.x)], 1u);
            asm volatile("s_waitcnt vmcnt(0)" ::: "memory");
        } else {
            XB_SPIN(xb_ld(&bar[XB_XGEN(b.x)]) == gen, bar);
            __builtin_amdgcn_fence(__ATOMIC_ACQUIRE, "agent");
            asm volatile("s_waitcnt vmcnt(0)" ::: "memory");
        }
    }
    __syncthreads();
}


struct Frame {
    LAS unsigned char* lds;
    volatile LAS unsigned* MISC;
    unsigned* ctl;
    int tid, lane, wave, vcu, G;
    const float *x_in, *gains, *w_in, *pool_w, *pool_scale, *conv_w, *rel_bias, *w_branch, *w_gate, *b_gate, *w_out, *w_up, *w_down;
    float* out;
    bf16 *Wcat1, *Wpool, *Wbr, *Wout, *Wup, *Wdown;
    bf16 *Hb, *PROJ, *GATES, *ABUF, *DP, *Y, *MP;
    float *SC, *TMP, *MX;
    unsigned long long* MASK;
};

__device__ __forceinline__ void conv_item(const float* W, int K, int Nsrc, int nblk, bf16* WT, LAS float* scr, int item, int lane) {
    const int kb = item / nblk, nb = item - kb * nblk, k0 = 64 * kb, n0 = 32 * nb;
    const int nl = n0 + (lane & 31); const bool ok = nl < Nsrc;
#pragma unroll 8
    for (int i = 0; i < 32; ++i) { const int kk = 2 * i + (lane >> 5); scr[kk * 33 + (lane & 31)] = ok ? W[(size_t)(k0 + kk) * Nsrc + nl] : 0.f; }
    LDS_WAIT(); asm volatile("" ::: "memory");
    const int c = lane & 7;
#pragma unroll
    for (int j = 0; j < 4; ++j) { const int n = (lane >> 3) + 8 * j; const LAS float* s = scr + (8 * c) * 33 + n;
        v4u o; o.x = pk2(s[0 * 33], s[1 * 33]); o.y = pk2(s[2 * 33], s[3 * 33]); o.z = pk2(s[4 * 33], s[5 * 33]); o.w = pk2(s[6 * 33], s[7 * 33]);
        *(GAS v4u*)(WT + (size_t)(n0 + n) * K + k0 + 8 * c) = o; }
    LDS_WAIT(); asm volatile("" ::: "memory");
}
__device__ __forceinline__ void convert_weights(Frame& F, int l) {
    int lane = F.lane; asm volatile("" : "+v"(lane));
    LAS float* scr = (LAS float*)(F.lds + RING_OFF + F.wave * 16384);
    const int gw = F.vcu * NWAVES + F.wave, NGW = F.G * NWAVES;
    constexpr int I0 = 32 * 216, I1 = 32 * 192, I2 = 4 * 32, I3 = 3 * 1024, I4 = 32 * 64, I5 = 32 * 256, I6 = 128 * 64;
    constexpr int NITEMS = I0 + I1 + I2 + I3 + I4 + I5 + I6;
    for (int it = gw; it < NITEMS; it += NGW) {
        int r = it;
        if (r < I0) { conv_item(F.w_in + (size_t)l * D * INW, D, INW, 216, F.Wcat1, scr, r, lane); continue; } r -= I0;
        if (r < I1) { conv_item(F.w_gate + (size_t)l * D * GW, D, GW, 192, F.Wcat1 + (size_t)INWP * D, scr, r, lane); continue; } r -= I1;
        if (r < I2) { const int g = r >> 5; conv_item(F.pool_w + ((size_t)l * 4 + g) * 65536, 256, 256, 8, F.Wpool + (size_t)g * 65536, scr, r & 31, lane); continue; } r -= I2;
        if (r < I3) { const int n = r >> 10; conv_item(F.w_branch + ((size_t)l * 3 + n) * 1024 * D, 1024, D, 64, F.Wbr + (size_t)n * D * 1024, scr, r & 1023, lane); continue; } r -= I3;
        if (r < I4) { conv_item(F.w_out + (size_t)l * D * D, D, D, 64, F.Wout, scr, r, lane); continue; } r -= I4;
        if (r < I5) { conv_item(F.w_up + (size_t)l * D * FF, D, FF, 256, F.Wup, scr, r, lane); continue; } r -= I5;
        conv_item(F.w_down + (size_t)l * FF * D, FF, D, 64, F.Wdown, scr, r, lane);
    }
}

__device__ __forceinline__ void store_h_row(bf16* orow, const f32x4 (&v)[8], const float* g, float rstd, int lane) {
    GAS v2u* o8 = (GAS v2u*)orow;
#pragma unroll
    for (int j = 0; j < 8; ++j) { const f32x4 gv = ((const f32x4*)g)[lane + 64 * j]; v2u w; w.x = pk2(v[j].x * rstd * gv.x, v[j].y * rstd * gv.y); w.y = pk2(v[j].z * rstd * gv.z, v[j].w * rstd * gv.w); o8[lane + 64 * j] = w; }
}
__device__ __forceinline__ void norm0_phase(Frame& F, const float* x, const float* g, bf16* h) {
    int lane = F.lane; asm volatile("" : "+v"(lane));
    const int gw = F.vcu * NWAVES + F.wave, NGW = F.G * NWAVES;
    for (int row = gw; row < M; row += NGW) {
        f32x4 v[8]; float s = 0.f;
#pragma unroll
        for (int j = 0; j < 8; ++j) { v[j] = ((const f32x4*)(x + (size_t)row * D))[lane + 64 * j]; s += (v[j].x * v[j].x + v[j].y * v[j].y) + (v[j].z * v[j].z + v[j].w * v[j].w); }
        const float rstd = 1.0f / sqrtf(wave_sum(s) * (1.0f / D) + EPS);
        store_h_row(h + (size_t)row * D, v, g, rstd, lane);
    }
}
__device__ __forceinline__ void resnorm_phase(Frame& F, const float* xsrc, float* xdst, const float* mbuf, const float* g_post, const float* g_pre, bf16* h) {
    int lane = F.lane; asm volatile("" : "+v"(lane));
    const int gw = F.vcu * NWAVES + F.wave, NGW = F.G * NWAVES;
    for (int row = gw; row < M; row += NGW) {
        f32x4 mv[8], xv[8]; float s = 0.f;
#pragma unroll
        for (int j = 0; j < 8; ++j) { mv[j] = ((const f32x4*)(mbuf + (size_t)row * D))[lane + 64 * j]; xv[j] = ((const f32x4*)(xsrc + (size_t)row * D))[lane + 64 * j];
            s += (mv[j].x * mv[j].x + mv[j].y * mv[j].y) + (mv[j].z * mv[j].z + mv[j].w * mv[j].w); }
        const float rstd = 1.0f / sqrtf(wave_sum(s) * (1.0f / D) + EPS);
        float s2 = 0.f;
#pragma unroll
        for (int j = 0; j < 8; ++j) { const f32x4 gv = ((const f32x4*)g_post)[lane + 64 * j]; xv[j] = xv[j] + mv[j] * gv * rstd;
            ((f32x4*)(xdst + (size_t)row * D))[lane + 64 * j] = xv[j];
            s2 += (xv[j].x * xv[j].x + xv[j].y * xv[j].y) + (xv[j].z * xv[j].z + xv[j].w * xv[j].w); }
        if (g_pre) { const float rstd2 = 1.0f / sqrtf(wave_sum(s2) * (1.0f / D) + EPS); store_h_row(h + (size_t)row * D, xv, g_pre, rstd2, lane); }
    }
}

__device__ __forceinline__ void poolconv_phase(Frame& F, const float* conv_w_l) {
    int tid = F.tid; asm volatile("" : "+v"(tid));
    const int gt = F.vcu * NTHR + tid, NGT = F.G * NTHR;
    for (int idx = gt; idx < M * 128; idx += NGT) {
        const int row = idx >> 7, c8 = (idx & 127) * 8, t = row & (SEQ - 1);
        {
            const int w = 2 << (c8 >> 8); const int lo = (t + 1 - w) > 0 ? (t + 1 - w) : 0;
            float s[8], u[8];
#pragma unroll
            for (int i = 0; i < 8; ++i) s[i] = 0.f;
            for (int ss = lo; ss <= t; ++ss) { unpack8(*(const v4u*)(F.PROJ + (size_t)(row - t + ss) * INWP + O_UPOOL + c8), u);
#pragma unroll
                for (int i = 0; i < 8; ++i) s[i] += u[i]; }
            const float inv = 1.0f / (float)(t + 1 - lo);
            v4u o; o.x = pk2(s[0] * inv - u[0], s[1] * inv - u[1]); o.y = pk2(s[2] * inv - u[2], s[3] * inv - u[3]); o.z = pk2(s[4] * inv - u[4], s[5] * inv - u[5]); o.w = pk2(s[6] * inv - u[6], s[7] * inv - u[7]);
            *(v4u*)(F.DP + (size_t)row * 1024 + c8) = o;
        }
        {
            float acc[8], a[8], b[8];
#pragma unroll
            for (int i = 0; i < 8; ++i) acc[i] = 0.f;
#pragma unroll
            for (int j = 0; j < 3; ++j) { const int tt = t - 2 + j;
                if (tt >= 0) { const bf16* pr = F.PROJ + (size_t)(row - 2 + j) * INWP; unpack8(*(const v4u*)(pr + O_CG + c8), a); unpack8(*(const v4u*)(pr + O_UCONV + c8), b);
                    const f32x4 w0 = *(const f32x4*)(conv_w_l + j * 1024 + c8), w1 = *(const f32x4*)(conv_w_l + j * 1024 + c8 + 4);
                    acc[0] += w0.x * (a[0] * b[0]); acc[1] += w0.y * (a[1] * b[1]); acc[2] += w0.z * (a[2] * b[2]); acc[3] += w0.w * (a[3] * b[3]);
                    acc[4] += w1.x * (a[4] * b[4]); acc[5] += w1.y * (a[5] * b[5]); acc[6] += w1.z * (a[6] * b[6]); acc[7] += w1.w * (a[7] * b[7]); } }
            unpack8(*(const v4u*)(F.PROJ + (size_t)row * INWP + O_BG + c8), a);
            v4u o; o.x = pk2(a[0] * acc[0], a[1] * acc[1]); o.y = pk2(a[2] * acc[2], a[3] * acc[3]); o.z = pk2(a[4] * acc[4], a[5] * acc[5]); o.w = pk2(a[6] * acc[6], a[7] * acc[7]);
            *(v4u*)(F.Y + (size_t)M * 1024 + (size_t)row * 1024 + c8) = o;
        }
    }
}

__device__ __forceinline__ void scores_phase_scalar(Frame& F) {
    int tid = F.tid; asm volatile("" : "+v"(tid));
    LAS float* qs = (LAS float*)(F.lds + RING_OFF);
    LAS float* wsm = (LAS float*)(F.lds + RING_OFF + 32768);
    for (int unit = blockIdx.x; unit < M / 8; unit += F.G) {
        const int row0 = unit * 8, b = row0 / SEQ, t0 = row0 % SEQ;
        __syncthreads();
        for (int i = tid; i < 8 * 1024; i += NTHR) qs[i] = bf2f(F.PROJ[(size_t)(row0 + (i >> 10)) * INWP + O_QI + (i & 1023)]);
        if (tid < 128) wsm[tid] = bf2f(F.PROJ[(size_t)(row0 + (tid >> 4)) * INWP + O_WI + (tid & 15)]) * 0.25f;
        __syncthreads();
        for (int s = tid; s <= t0 + 7; s += NTHR) {
            float kv[64];
            const bf16* kp = F.PROJ + (size_t)(b * SEQ + s) * INWP + O_KI;
#pragma unroll
            for (int c = 0; c < 8; ++c) { float t8[8]; unpack8(*(const v4u*)(kp + 8 * c), t8);
#pragma unroll
                for (int i = 0; i < 8; ++i) kv[8 * c + i] = t8[i]; }
            for (int r = 0; r < 8; ++r) {
                float tot = 0.f;
                for (int h = 0; h < IH; ++h) {
                    float dot = 0.f; const LAS float* qp = qs + r * 1024 + h * 64;
#pragma unroll
                    for (int d = 0; d < 64; ++d) dot = fmaf(qp[d], kv[d], dot);
                    tot += wsm[r * 16 + h] * fmaxf(dot, 0.f);
                }
                if (s <= t0 + r) F.SC[(size_t)(row0 + r) * SEQ + s] = tot;
            }
        }
    }
    __syncthreads();
}

__device__ __forceinline__ unsigned fkey(float f) { const unsigned u = __builtin_bit_cast(unsigned, f); return (u & 0x80000000u) ? ~u : (u | 0x80000000u); }
__device__ __forceinline__ int wave_isum(int v) {
#pragma unroll
    for (int o = 1; o < 64; o <<= 1) v += __shfl_xor(v, o);
    return v;
}
__device__ __forceinline__ void select_phase(Frame& F) {
    int lane = F.lane; asm volatile("" : "+v"(lane));
    const int gw = F.vcu * NWAVES + F.wave, NGW = F.G * NWAVES;
    for (int row = gw; row < M; row += NGW) {
        const int t = row & (SEQ - 1);
        const float* sr = F.SC + (size_t)row * SEQ;
        unsigned key[32];
#pragma unroll
        for (int j = 0; j < 32; ++j) { const int s = 64 * j + lane; key[j] = (s <= t) ? fkey(sr[s]) : 0u; }
        unsigned long long* mr = F.MASK + (size_t)row * 32;
        if (t + 1 <= TOPK) {
#pragma unroll
            for (int j = 0; j < 32; ++j) { const unsigned long long bm = __ballot(key[j] != 0u); if (lane == 0) mr[j] = bm; }
            continue;
        }
        unsigned T = 0u;
        for (int bit = 31; bit >= 0; --bit) {
            const unsigned cand = T | (1u << bit);
            int c = 0;
#pragma unroll
            for (int j = 0; j < 32; ++j) c += (key[j] >= cand) ? 1 : 0;
            c = wave_isum(c);
            if (c >= TOPK) T = cand;
        }
        int cg = 0;
#pragma unroll
        for (int j = 0; j < 32; ++j) cg += (key[j] > T) ? 1 : 0;
        cg = wave_isum(cg);
        const int need = TOPK - cg;
        int taken = 0;
#pragma unroll
        for (int j = 0; j < 32; ++j) {
            const unsigned long long eq = __ballot(key[j] == T);
            const int rank = taken + __popcll(eq & ((1ull << lane) - 1ull));
            const bool sel = (key[j] > T) || (key[j] == T && rank < need);
            taken += __popcll(eq);
            const unsigned long long bm = __ballot(sel);
            if (lane == 0) mr[j] = bm;
        }
    }
}

__device__ __forceinline__ int t5_bucket(int dist) {
    const int n = dist > 0 ? dist : 0;
    const float nf = (float)(n > 1 ? n : 1);
    int large = 16 + (int)(logf(nf / 16.0f) / 2.0794415416798357f * 16.0f);
    large = large < 31 ? large : 31;
    return n < 16 ? n : large;
}

__device__ __forceinline__ void attn_phase_scalar(Frame& F) {
    int lane = F.lane; asm volatile("" : "+v"(lane));
    const int gw = F.vcu * NWAVES + F.wave, NGW = F.G * NWAVES;
    bf16* YA = F.Y + (size_t)2 * M * 1024;
    for (int item = gw; item < M * NH; item += NGW) {
        const int row = item >> 3, h = item & 7, g = h >> 2, b = row / SEQ, t = row % SEQ;
        const unsigned qw = *(const unsigned*)(F.PROJ + (size_t)row * INWP + O_Q + h * HD + 2 * lane);
        const float q0 = bflo(qw), q1 = bfhi(qw);
        const unsigned long long* mr = F.MASK + (size_t)row * 32;
        float mx = -INFINITY, l = 0.f, o0 = 0.f, o1 = 0.f;
        const float scale = 0.08838834764831845f;
        for (int j = 0; j <= (t >> 6); ++j) {
            unsigned long long w = mr[j];
            while (w) {
                const int bpos = __ffsll((long long)w) - 1; w &= w - 1;
                const int s = 64 * j + bpos;
                if (s > t) continue;
                const bf16* kr = F.PROJ + (size_t)(b * SEQ + s) * INWP;
                const unsigned kw = *(const unsigned*)(kr + O_K + g * HD + 2 * lane), vw = *(const unsigned*)(kr + O_V + g * HD + 2 * lane);
                const float dot = wave_sum(q0 * bflo(kw) + q1 * bfhi(kw));
                const float logit = dot * scale + F.rel_bias[t5_bucket(t - s) * NH + h];
                const float nm = fmaxf(mx, logit);
                const float corr = __expf(mx - nm), p = __expf(logit - nm);
                l = l * corr + p; o0 = o0 * corr + p * bflo(vw); o1 = o1 * corr + p * bfhi(vw);
                mx = nm;
            }
        }
        const float inv = 1.0f / l;
        *(unsigned*)(YA + (size_t)row * 1024 + h * HD + 2 * lane) = pk2(o0 * inv, o1 * inv);
    }
}


typedef short bf16x8 __attribute__((ext_vector_type(8)));
typedef float f32x16 __attribute__((ext_vector_type(16)));
__device__ __forceinline__ void scores_phase_mfma(Frame& F) {
    int lane = F.lane; asm volatile("" : "+v"(lane));
    const int c = lane & 15, q4 = lane >> 4, wave = F.wave;
    for (int rep = 0; rep < 2; ++rep) {
        const int j = blockIdx.x, b = j >> 6, i = j & 63, tb = rep == 0 ? 127 - i : i, t0 = tb * 16, nt = tb + 1;
        const bf16* qrow = F.PROJ + (size_t)(b * SEQ + t0 + c) * INWP + O_QI + 8 * q4;
        bf16x8 qa[16][2];
#pragma unroll
        for (int h = 0; h < 16; ++h)
#pragma unroll
            for (int ks = 0; ks < 2; ++ks) qa[h][ks] = *(const bf16x8*)(qrow + h * 64 + 32 * ks);
        float wv[4][16];
#pragma unroll
        for (int r = 0; r < 4; ++r) { const bf16* wp = F.PROJ + (size_t)(b * SEQ + t0 + 4 * q4 + r) * INWP + O_WI; float t8[8];
            unpack8(*(const v4u*)wp, t8);
#pragma unroll
            for (int k = 0; k < 8; ++k) wv[r][k] = t8[k];
            unpack8(*(const v4u*)(wp + 8), t8);
#pragma unroll
            for (int k = 0; k < 8; ++k) wv[r][8 + k] = t8[k]; }
        const bf16* kbase = F.PROJ + (size_t)(b * SEQ + c) * INWP + O_KI + 8 * q4;
        float* srow = F.SC + (size_t)(b * SEQ + t0 + 4 * q4) * SEQ + c;
        bf16x8 kb0, kb1;
        if (wave < nt) { const bf16* kp = kbase + (size_t)(wave * 16) * INWP; kb0 = *(const bf16x8*)kp; kb1 = *(const bf16x8*)(kp + 32); }
        for (int kt = wave; kt < nt; kt += NWAVES) {
            const bf16x8 b0 = kb0, b1 = kb1;
            if (kt + NWAVES < nt) { const bf16* kp = kbase + (size_t)((kt + NWAVES) * 16) * INWP; kb0 = *(const bf16x8*)kp; kb1 = *(const bf16x8*)(kp + 32); }
            f32x4 tot = {0.f, 0.f, 0.f, 0.f};
#pragma unroll
            for (int h = 0; h < 16; ++h) {
                f32x4 acc = {0.f, 0.f, 0.f, 0.f};
                acc = __builtin_amdgcn_mfma_f32_16x16x32_bf16(qa[h][0], b0, acc, 0, 0, 0);
                acc = __builtin_amdgcn_mfma_f32_16x16x32_bf16(qa[h][1], b1, acc, 0, 0, 0);
#pragma unroll
                for (int r = 0; r < 4; ++r) tot[r] += wv[r][h] * fmaxf(acc[r], 0.f);
            }
#pragma unroll
            for (int r = 0; r < 4; ++r) srow[(size_t)r * SEQ + kt * 16] = tot[r];
        }
    }
}

constexpr int AT_KPITCH = 272, AT_VPITCH = 72;
constexpr int AT_KBUF = 0, AT_VBUF = 2 * 32 * AT_KPITCH, AT_LUT = AT_VBUF + 2 * 128 * AT_VPITCH, AT_MERGE = 40960, AT_END = AT_MERGE + 4 * 66 * 64 * 4;
static_assert(AT_LUT + 8 * 132 * 4 <= AT_MERGE && AT_END <= RING_BYTES, "attention LDS map");
__device__ __forceinline__ void attn_phase_mfma(Frame& F) {
    int tid = F.tid; asm volatile("" : "+v"(tid));
    const int lane = tid & 63, wave = F.wave, grp = wave >> 2, hr = wave & 3, c = lane & 31, hh = lane >> 5, tg = tid & 255;
    LAS unsigned char* KB = F.lds + RING_OFF + AT_KBUF + grp * (32 * AT_KPITCH);
    LAS unsigned char* VB = F.lds + RING_OFF + AT_VBUF + grp * (128 * AT_VPITCH);
    LAS float* LUT = (LAS float*)(F.lds + RING_OFF + AT_LUT);
    LAS float* MG = (LAS float*)(F.lds + RING_OFF + AT_MERGE) + hr * (66 * 64);
    const float LOG2E = 1.4426950408889634f, C1 = 0.08838834764831845f * 1.4426950408889634f;
    __syncthreads();
    for (int idx = tid; idx < 8 * 129; idx += NTHR) { const int hd = idx / 129, d = idx - hd * 129; LUT[hd * 132 + d] = F.rel_bias[t5_bucket(d) * NH + hd] * LOG2E; }
    __syncthreads();
    bf16* YA = F.Y + (size_t)2 * M * 1024;
    const unsigned* maskw = (const unsigned*)F.MASK;
    for (int rep = 0; rep < 2; ++rep) {
        const int j = blockIdx.x, bg = j >> 5, i = j & 31, qb = rep == 0 ? 63 - i : i, b = bg >> 1, g = bg & 1, h = 4 * g + hr;
        const int q0 = qb * 32, tq = q0 + c; const size_t row_q = (size_t)(b * SEQ + tq);
        bf16x8 qf[8];
#pragma unroll
        for (int ks = 0; ks < 8; ++ks) qf[ks] = *(const bf16x8*)(F.PROJ + row_q * INWP + O_Q + h * HD + 16 * ks + 8 * hh);
        f32x16 o[4];
#pragma unroll
        for (int db = 0; db < 4; ++db)
#pragma unroll
            for (int r = 0; r < 16; ++r) o[db][r] = 0.f;
        float m = -INFINITY, l = 0.f;
        const int nsteps = (qb + 2) >> 1;
        const bf16* kvb = F.PROJ + (size_t)(b * SEQ) * INWP + g * HD;
        v4u sk[2], sv[2];
        {
            const int kt = grp;
            if (kt <= qb) {
#pragma unroll
                for (int u = 0; u < 2; ++u) { const int ck = tg + 256 * u; sk[u] = *(const v4u*)(kvb + (size_t)(kt * 32 + (ck >> 4)) * INWP + O_K + (ck & 15) * 8); }
#pragma unroll
                for (int u = 0; u < 2; ++u) sv[u] = *(const v4u*)(kvb + (size_t)(kt * 32 + 2 * (tg & 15) + u) * INWP + O_V + (tg >> 4) * 8);
            }
        }
        for (int st = 0; st < nsteps; ++st) {
            const int kt = 2 * st + grp; const bool valid = kt <= qb;
            if (valid) {
#pragma unroll
                for (int u = 0; u < 2; ++u) { const int ck = tg + 256 * u; *(LAS v4u*)(KB + (ck >> 4) * AT_KPITCH + (ck & 15) * 16) = sk[u]; }
                const int kp = tg & 15, dc = tg >> 4;
                const unsigned a0[4] = {sv[0].x, sv[0].y, sv[0].z, sv[0].w}, a1[4] = {sv[1].x, sv[1].y, sv[1].z, sv[1].w};
#pragma unroll
                for (int e = 0; e < 4; ++e) {
                    *(LAS unsigned*)(VB + (dc * 8 + 2 * e) * AT_VPITCH + kp * 4) = (a0[e] & 0xffffu) | (a1[e] << 16);
                    *(LAS unsigned*)(VB + (dc * 8 + 2 * e + 1) * AT_VPITCH + kp * 4) = (a0[e] >> 16) | (a1[e] & 0xffff0000u);
                }
            }
            __syncthreads();
            unsigned mw = 0u;
            if (valid) mw = maskw[row_q * 64 + kt];
            {
                const int ktn = kt + 2;
                if (ktn <= qb) {
#pragma unroll
                    for (int u = 0; u < 2; ++u) { const int ck = tg + 256 * u; sk[u] = *(const v4u*)(kvb + (size_t)(ktn * 32 + (ck >> 4)) * INWP + O_K + (ck & 15) * 8); }
#pragma unroll
                    for (int u = 0; u < 2; ++u) sv[u] = *(const v4u*)(kvb + (size_t)(ktn * 32 + 2 * (tg & 15) + u) * INWP + O_V + (tg >> 4) * 8);
                }
            }
            if (valid) {
                const int key0 = kt * 32;
                f32x16 s;
#pragma unroll
                for (int r = 0; r < 16; ++r) s[r] = 0.f;
#pragma unroll
                for (int ks = 0; ks < 8; ++ks) { const bf16x8 a = *(const LAS bf16x8*)(KB + c * AT_KPITCH + (16 * ks + 8 * hh) * 2); s = __builtin_amdgcn_mfma_f32_32x32x16_bf16(a, qf[ks], s, 0, 0, 0); }
                const bool far = (q0 - key0 - 31) >= 128;
                const float bfar = LUT[h * 132 + 128];
                float tmax = -INFINITY;
#pragma unroll
                for (int r = 0; r < 16; ++r) {
                    const int koff = (r & 3) + 8 * (r >> 2) + 4 * hh;
                    float bias = bfar;
                    if (!far) { int dist = tq - (key0 + koff); dist = dist < 0 ? 0 : (dist > 128 ? 128 : dist); bias = LUT[h * 132 + dist]; }
                    const float v = ((mw >> koff) & 1u) ? (s[r] * C1 + bias) : -INFINITY;
                    s[r] = v; tmax = fmaxf(tmax, v);
                }
                tmax = fmaxf(tmax, __shfl_xor(tmax, 32));
                const float mn = fmaxf(m, tmax), ms = (mn == -INFINITY) ? 0.f : mn;
                const float corr = __builtin_amdgcn_exp2f(m - ms);
                float rs = 0.f;
#pragma unroll
                for (int r = 0; r < 16; ++r) { const float p = __builtin_amdgcn_exp2f(s[r] - ms); s[r] = p; rs += p; }
                l = l * corr + rs; m = mn;
#pragma unroll
                for (int db = 0; db < 4; ++db)
#pragma unroll
                    for (int r = 0; r < 16; ++r) o[db][r] *= corr;
                bf16x8 pf[2];
#pragma unroll
                for (int s2 = 0; s2 < 2; ++s2) { v4u w; w.x = pg8::cvt_pk_bf16(s[8 * s2 + 0], s[8 * s2 + 1]); w.y = pg8::cvt_pk_bf16(s[8 * s2 + 2], s[8 * s2 + 3]); w.z = pg8::cvt_pk_bf16(s[8 * s2 + 4], s[8 * s2 + 5]); w.w = pg8::cvt_pk_bf16(s[8 * s2 + 6], s[8 * s2 + 7]); pf[s2] = __builtin_bit_cast(bf16x8, w); }
#pragma unroll
                for (int db = 0; db < 4; ++db)
#pragma unroll
                    for (int s2 = 0; s2 < 2; ++s2) {
                        const LAS unsigned char* vp = VB + (32 * db + c) * AT_VPITCH + (16 * s2 + 4 * hh) * 2;
                        const v2u lo = *(const LAS v2u*)vp, hi = *(const LAS v2u*)(vp + 16);
                        v4u w; w.x = lo.x; w.y = lo.y; w.z = hi.x; w.w = hi.y;
                        o[db] = __builtin_amdgcn_mfma_f32_32x32x16_bf16(__builtin_bit_cast(bf16x8, w), pf[s2], o[db], 0, 0, 0);
                    }
            }
            __syncthreads();
        }
        if (grp == 1) {
#pragma unroll
            for (int db = 0; db < 4; ++db)
#pragma unroll
                for (int r = 0; r < 16; ++r) MG[(db * 16 + r) * 64 + lane] = o[db][r];
            MG[64 * 64 + lane] = m; MG[65 * 64 + lane] = l;
        }
        __syncthreads();
        if (grp == 0) {
            const float m2 = MG[64 * 64 + lane], l2 = MG[65 * 64 + lane];
            const float mn = fmaxf(m, m2), ms = (mn == -INFINITY) ? 0.f : mn;
            const float fa = __builtin_amdgcn_exp2f(m - ms), fb = __builtin_amdgcn_exp2f(m2 - ms);
            float lt = l * fa + l2 * fb; lt += __shfl_xor(lt, 32);
            const float inv = 1.0f / lt;
            bf16* yp = YA + row_q * 1024 + h * HD + 4 * hh;
#pragma unroll
            for (int db = 0; db < 4; ++db)
#pragma unroll
                for (int rg = 0; rg < 4; ++rg) {
                    float v[4];
#pragma unroll
                    for (int e = 0; e < 4; ++e) v[e] = (o[db][4 * rg + e] * fa + MG[(db * 16 + 4 * rg + e) * 64 + lane] * fb) * inv;
                    v2u w; w.x = pg8::cvt_pk_bf16(v[0], v[1]); w.y = pg8::cvt_pk_bf16(v[2], v[3]);
                    *(v2u*)(yp + 32 * db + 8 * rg) = w;
                }
        }
        __syncthreads();
    }
}

struct Args { const float* in[13]; float* out; unsigned char* ws; int ph_lo, ph_hi; };
__global__ void __launch_bounds__(NTHR, 2) mk_fwd(Args args) {
    extern __shared__ __attribute__((aligned(16))) unsigned char lds[];
    Frame F;
    F.lds = (LAS unsigned char*)lds;
    F.MISC = (volatile LAS unsigned*)(F.lds + MISC_OFF);
    F.tid = threadIdx.x; F.lane = F.tid & 63; F.wave = __builtin_amdgcn_readfirstlane(F.tid >> 6);
    F.G = gridDim.x; { const int bx = blockIdx.x; F.vcu = (F.G % 8 == 0) ? (bx % 8) * (F.G / 8) + bx / 8 : bx; }
    unsigned char* ws = args.ws;
    F.ctl = (unsigned*)(ws + WS_CTL);
    F.x_in = args.in[0]; F.gains = args.in[1]; F.w_in = args.in[2]; F.pool_w = args.in[3]; F.pool_scale = args.in[4]; F.conv_w = args.in[5]; F.rel_bias = args.in[6];
    F.w_branch = args.in[7]; F.w_gate = args.in[8]; F.b_gate = args.in[9]; F.w_out = args.in[10]; F.w_up = args.in[11]; F.w_down = args.in[12]; F.out = args.out;
    F.Wcat1 = (bf16*)(ws + WS_WCAT1); F.Wpool = (bf16*)(ws + WS_WPOOL); F.Wbr = (bf16*)(ws + WS_WBR); F.Wout = (bf16*)(ws + WS_WOUT); F.Wup = (bf16*)(ws + WS_WUP); F.Wdown = (bf16*)(ws + WS_WDOWN);
    F.Hb = (bf16*)(ws + WS_H); F.PROJ = (bf16*)(ws + WS_PROJ); F.GATES = (bf16*)(ws + WS_GATES); F.ABUF = (bf16*)(ws + WS_ABUF); F.DP = (bf16*)(ws + WS_DP); F.Y = (bf16*)(ws + WS_Y); F.MP = (bf16*)(ws + WS_MP);
    F.SC = (float*)(ws + WS_SC); F.TMP = (float*)(ws + WS_TMP); F.MX = (float*)(ws + WS_MX); F.MASK = (unsigned long long*)(ws + WS_MASK);
    for (int u = F.tid; u < (LDS_BYTES - LDSCTL_OFF) / 4; u += NTHR) ((LAS unsigned*)(F.lds + LDSCTL_OFF))[u] = 0u;
    __syncthreads();
    XcdBarrier bar; bar.bar = F.ctl + CW_BAR; bar.x = 0; bar.st = nullptr;
    if (!MK_SPLIT) bar = xcd_barrier_post(F.ctl + CW_BAR, F.MISC + 8);
#define GRID_BAR() do { if (!MK_SPLIT) xcd_barrier(bar); } while (0)
    const int lo = args.ph_lo, hi = args.ph_hi;
#define IN(k) (lo <= (k) && (k) < hi)
    LAS unsigned char* ring = F.lds + RING_OFF;

    if (IN(0)) { convert_weights(F, 0); norm0_phase(F, F.x_in, F.gains, F.Hb); GRID_BAR(); }

    for (int l = 0; l < DEPTH; ++l) {
        const int pb = 1 + l * NPH;
        const float* g = F.gains + (size_t)l * 4 * D;
        if (IN(pb + 0)) {
            pg8::Gemm gm{F.Hb, F.Wcat1, D, D, D, 0, 0, 0}; pg8::StaticOrder S; S.init(M, N1, F.G, (int)blockIdx.x);
            pg8::EpiProjGate E{F.PROJ, INWP, F.GATES, GW, F.b_gate + (size_t)l * GW, NPJ};
            pg8::gemm_phase<pg8::EpiProjGate, pg8::StaticOrder, true, true>(ring, gm, S, E);
            GRID_BAR();
        }
        if (IN(pb + 1)) { poolconv_phase(F, F.conv_w + (size_t)l * 3 * 1024); if (USE_MFMA_SC) scores_phase_mfma(F); else scores_phase_scalar(F); GRID_BAR(); }
        if (IN(pb + 2)) {
            pg8::Gemm gm{F.DP, F.Wpool, 1024, 256, 256, 256, 0, 0}; pg8::StaticOrder S; S.init(M, 1024, F.G, (int)blockIdx.x);
            pg8::EpiBf16<2> E{F.Y, 1024, F.pool_scale + (size_t)l * 1024};
            pg8::gemm_phase<pg8::EpiBf16<2>, pg8::StaticOrder, true, true>(ring, gm, S, E);
            select_phase(F);
            GRID_BAR();
        }
        if (IN(pb + 3)) { if (USE_MFMA_AT) attn_phase_mfma(F); else attn_phase_scalar(F); GRID_BAR(); }
        if (IN(pb + 4)) {
            pg8::Gemm gm{F.Y, F.Wbr, 1024, 1024, 1024, 0, (long)M * 1024, (long)D * 1024}; pg8::StaticOrder S; S.init(M, D, F.G, (int)blockIdx.x, 3);
            pg8::EpiBranch E{F.GATES, GW, D, F.TMP, F.MP, D, 3};
            pg8::gemm_phase<pg8::EpiBranch, pg8::StaticOrder, true, true>(ring, gm, S, E);
            GRID_BAR();
        }
        if (IN(pb + 5)) {
            pg8::Gemm gm{F.MP, F.Wout, D, D, D, 0, 0, 0}; pg8::StaticOrder S; S.init(M, D, F.G, (int)blockIdx.x);
            pg8::EpiF32 E{F.MX, D};
            pg8::gemm_phase<pg8::EpiF32, pg8::StaticOrder, true, true>(ring, gm, S, E);
            GRID_BAR();
        }
        if (IN(pb + 6)) { resnorm_phase(F, l == 0 ? F.x_in : F.out, F.out, F.MX, g + D, g + 2 * D, F.Hb); GRID_BAR(); }
        if (IN(pb + 7)) {
            pg8::Gemm gm{F.Hb, F.Wup, D, D, D, 0, 0, 0}; pg8::StaticOrder S; S.init(M, FF, F.G, (int)blockIdx.x);
            pg8::EpiBf16<1> E{F.ABUF, FF, nullptr};
            pg8::gemm_phase<pg8::EpiBf16<1>, pg8::StaticOrder, true, true>(ring, gm, S, E);
            GRID_BAR();
        }
        if (IN(pb + 8)) {
            pg8::Gemm gm{F.ABUF, F.Wdown, FF, FF, FF, 0, 0, 0}; pg8::StaticOrder S; S.init(M, D, F.G, (int)blockIdx.x);
            pg8::EpiF32 E{F.MX, D};
            pg8::gemm_phase<pg8::EpiF32, pg8::StaticOrder, true, true>(ring, gm, S, E);
            GRID_BAR();
        }
        if (IN(pb + 9)) {
            if (l + 1 < DEPTH) { convert_weights(F, l + 1); resnorm_phase(F, F.out, F.out, F.MX, g + 3 * D, g + 4 * D, F.Hb); GRID_BAR(); }
            else resnorm_phase(F, F.out, F.out, F.MX, g + 3 * D, nullptr, nullptr);
        }
    }
#undef IN
#undef GRID_BAR
}

extern "C" void kernel_launch(void* const* d_in, const int* in_sizes, int n_in, void* d_out, int out_size, void* d_ws, size_t ws_size, hipStream_t stream) {
    static int grid = 0;
    if (grid == 0) {
        if (n_in != 13 || out_size != M * D || ws_size < WS_END) { fprintf(stderr, "kernel_launch: unexpected shapes (n_in %d out %d ws %zu need %zu); nothing launched\n", n_in, out_size, ws_size, (size_t)WS_END); grid = -1; return; }
        int dev = 0, cus = 0, per_cu = 0;
        if (hipGetDevice(&dev) != hipSuccess || hipDeviceGetAttribute(&cus, hipDeviceAttributeMultiprocessorCount, dev) != hipSuccess) { grid = -1; return; }
        if (hipFuncSetAttribute((const void*)mk_fwd, hipFuncAttributeMaxDynamicSharedMemorySize, LDS_BYTES) != hipSuccess) { fprintf(stderr, "kernel_launch: hipFuncSetAttribute failed\n"); grid = -1; return; }
        if (hipOccupancyMaxActiveBlocksPerMultiprocessor(&per_cu, (const void*)mk_fwd, NTHR, LDS_BYTES) != hipSuccess || per_cu < 1) { fprintf(stderr, "kernel_launch: occupancy query says %d\n", per_cu); }
        (void)hipGetLastError();
        grid = cus;
    }
    if (grid < 0) return;
    if (hipMemsetAsync((char*)d_ws + WS_CTL, 0, CTL_ZERO_BYTES, stream) != hipSuccess) return;
    Args a{};
    for (int i = 0; i < 13; ++i) a.in[i] = (const float*)d_in[i];
    a.out = (float*)d_out; a.ws = (unsigned char*)d_ws;
#if MK_SPLIT
    for (int p = 0; p < 1 + DEPTH * NPH; ++p) { a.ph_lo = p; a.ph_hi = p + 1; hipLaunchKernelGGL(mk_fwd, dim3(grid), dim3(NTHR), LDS_BYTES, stream, a); }
#else
    a.ph_lo = 0; a.ph_hi = 1 << 20;
    hipLaunchKernelGGL(mk_fwd, dim3(grid), dim3(NTHR), LDS_BYTES, stream, a);
#endif
}
```

```cpp
#include <hip/hip_runtime.h>
#include <cstdio>
#include <cstdint>

#ifndef MK_SPLIT
#define MK_SPLIT 0
#endif

namespace pg8 {
#define PG8_LAS __attribute__((address_space(3)))
typedef unsigned short bf16_t;
typedef short bf16x8 __attribute__((ext_vector_type(8)));
typedef float f32x4 __attribute__((ext_vector_type(4)));
typedef float f32x2 __attribute__((ext_vector_type(2)));
typedef unsigned u32x4 __attribute__((ext_vector_type(4)));
constexpr int BM = 256, BK = 64, HALF = 128, HTB = HALF * BK * 2  , STAGE_BYTES = 8 * HTB, NXCD = 8, WGM = 8;

__host__ __device__ __forceinline__ int lds_byte(int r, int c) { const int st = (r >> 4) * 2 + (c >> 5), rr = r & 15, cc = c & 31, ob = rr * 64 + cc * 2; return st * 1024 + (ob ^ (((ob >> 9) & 1) << 5)); }
__host__ __device__ __forceinline__ void stage_rc(int b, int& R, int& C) { const int st = b / 1024, sb = b % 1024, swz = sb ^ (((sb >> 9) & 1) << 5); R = (st >> 1) * 16 + swz / 64; C = (st & 1) * 32 + (swz % 64) / 2; }
__host__ __device__ __forceinline__ int perm32(int rho) { const int n = rho >> 4, i = rho & 15; return 8 * (i >> 2) + 4 * n + (i & 3); }

struct Unit { int pm, pn, sub; };
struct Gemm {
    const bf16_t* A; const bf16_t* Bt; int lda, ldb, K; long a_pn, a_sub, b_sub;
    __device__ __forceinline__ const char* pa(const Unit& u) const { return (const char*)(A + ((size_t)u.pm * BM * lda + (size_t)u.pn * a_pn + (size_t)u.sub * a_sub)); }
    __device__ __forceinline__ const char* pb(const Unit& u) const { return (const char*)(Bt + ((size_t)u.pn * BM * ldb + (size_t)u.sub * b_sub)); }
};

struct StaticOrder {
    int nM, nN, nwg, G, c, subs;
    __host__ __device__ void init(int M, int N, int G_, int c_, int subs_ = 1) { nM = M / BM; nN = N / BM; nwg = nM * nN; G = G_; c = c_; subs = subs_; }
    __host__ __device__ bool next(int i, Unit& u) const {
        const int ti = i / subs;
        const long L = (long)ti * G + c; if (L >= nwg) return false;
        int wgid = (int)L; { const int q = nwg / NXCD, r = nwg % NXCD, xcd = wgid % NXCD, off = wgid / NXCD; wgid = (xcd < r ? xcd * (q + 1) : r * (q + 1) + (xcd - r) * q) + off; }
        const int nig = WGM * nN, gid = wgid / nig, fm = gid * WGM, gsz = (nM - fm) < WGM ? (nM - fm) : WGM;
        u.pm = fm + ((wgid % nig) % gsz); u.pn = (wgid % nig) / gsz; u.sub = i - ti * subs; return true;
    }
    __device__ __forceinline__ void a_ready(const Unit&) const {}
    __device__ __forceinline__ void done(const Unit&) const {}
};

typedef __bf16 bf16x2_t __attribute__((ext_vector_type(2)));
__device__ __forceinline__ unsigned cvt_pk_bf16(float lo, float hi) { const f32x2 v = {lo, hi}; return __builtin_bit_cast(unsigned, __builtin_convertvector(v, bf16x2_t)); }
__device__ __forceinline__ float bflo(unsigned w) { return __builtin_bit_cast(float, w << 16); }
__device__ __forceinline__ float bfhi(unsigned w) { return __builtin_bit_cast(float, w & 0xffff0000u); }
__device__ __forceinline__ u32x4 pack8(const f32x4& v0, const f32x4& v1) { u32x4 w; w.x = cvt_pk_bf16(v0[0], v0[1]); w.y = cvt_pk_bf16(v0[2], v0[3]); w.z = cvt_pk_bf16(v1[0], v1[1]); w.w = cvt_pk_bf16(v1[2], v1[3]); return w; }

struct EpiF32 {
    static constexpr bool PERM = false, AFTER_DRAIN = false;
    float* C; int ldc;
    __device__ __forceinline__ void operator()(const f32x4 (&acc)[2][2][4][2], const Unit& u, int wr, int wc, int fr_, int fq_) const {
        int fr = fr_, fq = fq_; asm volatile("" : "+v"(fr), "+v"(fq));
        const int row0 = u.pm * BM + wr * 64 + fr, col0 = u.pn * BM + wc * 32 + 4 * fq;
#pragma unroll
        for (int ai = 0; ai < 2; ++ai)
#pragma unroll
            for (int m = 0; m < 4; ++m) { float* rowp = C + (size_t)(row0 + ai * HALF + m * 16) * ldc + col0;
#pragma unroll
                for (int bj = 0; bj < 2; ++bj)
#pragma unroll
                    for (int n = 0; n < 2; ++n) *(f32x4*)(rowp + bj * HALF + n * 16) = acc[ai][bj][m][n]; }
    }
};
template <int ACT> struct EpiBf16 {
    static constexpr bool PERM = true, AFTER_DRAIN = false;
    bf16_t* O; int ldc; const float* vec;
    __device__ __forceinline__ void operator()(const f32x4 (&acc)[2][2][4][2], const Unit& u, int wr, int wc, int fr_, int fq_) const {
        int fr = fr_, fq = fq_; asm volatile("" : "+v"(fr), "+v"(fq));
        const int row0 = u.pm * BM + wr * 64 + fr, col0 = u.pn * BM + wc * 32 + 8 * fq;
        f32x4 sv[2][2];
        if (ACT == 2) {
#pragma unroll
            for (int bj = 0; bj < 2; ++bj)
#pragma unroll
                for (int n = 0; n < 2; ++n) sv[bj][n] = *(const f32x4*)(vec + col0 + bj * HALF + 4 * n);
        }
#pragma unroll
        for (int ai = 0; ai < 2; ++ai)
#pragma unroll
            for (int m = 0; m < 4; ++m) { bf16_t* rowp = O + (size_t)(row0 + ai * HALF + m * 16) * ldc + col0;
#pragma unroll
                for (int bj = 0; bj < 2; ++bj) { f32x4 v0 = acc[ai][bj][m][0], v1 = acc[ai][bj][m][1];
                    if (ACT == 1) {
#pragma unroll
                        for (int j = 0; j < 4; ++j) { const float a = fmaxf(v0[j], 0.f), b = fmaxf(v1[j], 0.f); v0[j] = a * a; v1[j] = b * b; } }
                    if (ACT == 2) { v0 = v0 * sv[bj][0]; v1 = v1 * sv[bj][1]; }
                    *(u32x4*)(rowp + bj * HALF) = pack8(v0, v1); } }
    }
};
struct EpiProjGate {
    static constexpr bool PERM = true, AFTER_DRAIN = false;
    bf16_t* P; int ldp; bf16_t* Gt; int ldg; const float* bias; int npj;
    __device__ __forceinline__ void operator()(const f32x4 (&acc)[2][2][4][2], const Unit& u, int wr, int wc, int fr_, int fq_) const {
        int fr = fr_, fq = fq_; asm volatile("" : "+v"(fr), "+v"(fq));
        const int row0 = u.pm * BM + wr * 64 + fr;
        if (u.pn < npj) {
            const int col0 = u.pn * BM + wc * 32 + 8 * fq;
#pragma unroll
            for (int ai = 0; ai < 2; ++ai)
#pragma unroll
                for (int m = 0; m < 4; ++m) { bf16_t* rowp = P + (size_t)(row0 + ai * HALF + m * 16) * ldp + col0;
#pragma unroll
                    for (int bj = 0; bj < 2; ++bj) *(u32x4*)(rowp + bj * HALF) = pack8(acc[ai][bj][m][0], acc[ai][bj][m][1]); }
        } else {
            const int col0 = (u.pn - npj) * BM + wc * 32 + 8 * fq;
            f32x4 bv[2][2];
#pragma unroll
            for (int bj = 0; bj < 2; ++bj)
#pragma unroll
                for (int n = 0; n < 2; ++n) bv[bj][n] = *(const f32x4*)(bias + col0 + bj * HALF + 4 * n);
#pragma unroll
            for (int ai = 0; ai < 2; ++ai)
#pragma unroll
                for (int m = 0; m < 4; ++m) { bf16_t* rowp = Gt + (size_t)(row0 + ai * HALF + m * 16) * ldg + col0;
#pragma unroll
                    for (int bj = 0; bj < 2; ++bj) { f32x4 v0 = acc[ai][bj][m][0] + bv[bj][0], v1 = acc[ai][bj][m][1] + bv[bj][1];
#pragma unroll
                        for (int j = 0; j < 4; ++j) { v0[j] = __builtin_amdgcn_rcpf(1.0f + __expf(-v0[j])); v1[j] = __builtin_amdgcn_rcpf(1.0f + __expf(-v1[j])); }
                        *(u32x4*)(rowp + bj * HALF) = pack8(v0, v1); } }
        }
    }
};
struct EpiBranch {
    static constexpr bool PERM = true, AFTER_DRAIN = false;
    const bf16_t* Gt; int ldg; int gsub; float* tmp; bf16_t* O; int ldc; int nsub;
    __device__ __forceinline__ void operator()(const f32x4 (&acc)[2][2][4][2], const Unit& u, int wr, int wc, int fr_, int fq_) const {
        int fr = fr_, fq = fq_; asm volatile("" : "+v"(fr), "+v"(fq));
        const int row0 = u.pm * BM + wr * 64 + fr, col0 = u.pn * BM + wc * 32 + 8 * fq;
#pragma unroll
        for (int ai = 0; ai < 2; ++ai)
#pragma unroll
            for (int m = 0; m < 4; ++m) { const size_t r = (size_t)(row0 + ai * HALF + m * 16);
#pragma unroll
                for (int bj = 0; bj < 2; ++bj) { const int c = col0 + bj * HALF;
                    const u32x4 gw = *(const u32x4*)(Gt + r * ldg + (size_t)u.sub * gsub + c);
                    f32x4 v0 = acc[ai][bj][m][0], v1 = acc[ai][bj][m][1];
                    v0[0] *= bflo(gw.x); v0[1] *= bfhi(gw.x); v0[2] *= bflo(gw.y); v0[3] *= bfhi(gw.y);
                    v1[0] *= bflo(gw.z); v1[1] *= bfhi(gw.z); v1[2] *= bflo(gw.w); v1[3] *= bfhi(gw.w);
                    float* tp = tmp + r * ldc + c;
                    if (u.sub > 0) { v0 = v0 + *(const f32x4*)tp; v1 = v1 + *(const f32x4*)(tp + 4); }
                    if (u.sub < nsub - 1) { *(f32x4*)tp = v0; *(f32x4*)(tp + 4) = v1; }
                    else *(u32x4*)(O + r * ldc + c) = pack8(v0, v1); } }
    }
};

template <class Epi, class Sched, bool ALIGN_EPI = false, bool SP2 = false>
__device__ __forceinline__ void gemm_phase(PG8_LAS unsigned char* lds, const Gemm g_in, const Sched& S, const Epi& E) {
    Gemm g = g_in; asm volatile("" : "+s"(g.A), "+s"(g.Bt));
    int tid_l = threadIdx.x; asm volatile("" : "+v"(tid_l));
    const int tid = tid_l, wid = __builtin_amdgcn_readfirstlane(tid >> 6), lane = tid & 63, wr = wid >> 2, wc = wid & 3, fr = lane & 15, fq = lane >> 4;
    const int K = g.K, nt = K / BK;
    unsigned voffA[2], voffB[2];
#pragma unroll
    for (int i = 0; i < 2; ++i) { int R, C; stage_rc(tid * 16 + i * 8192, R, C); const int Rb = Epi::PERM ? ((R & ~31) + perm32(R & 31)) : R;
        voffA[i] = (unsigned)(R * g.lda + C) * 2u; voffB[i] = (unsigned)(Rb * g.ldb + C) * 2u; }
    const size_t kstep = (size_t)(BK * 2);
    const size_t hstepA = (size_t)HALF * g.lda * 2, hstepB = (size_t)HALF * g.ldb * 2;
    const unsigned ldsw = (unsigned)wid * 1024u;
    const int aoff = lds_byte(wr * 64 + fr, fq * 8), boff = lds_byte(wc * 32 + fr, fq * 8);
#define PG8_SA(b, h) (((b) * 2 + (h)) * HTB)
#define PG8_SB(b, h) ((4 + (b) * 2 + (h)) * HTB)
#define PG8_STAGE(bufoff, gbase, voff) do { _Pragma("unroll") for (int _i = 0; _i < 2; ++_i) \
        __builtin_amdgcn_global_load_lds((const unsigned*)((const char*)(gbase) + (voff)[_i]), (PG8_LAS unsigned*)(lds + (bufoff) + ldsw + _i * 8192), 16, 0, 0); } while (0)
#define PG8_LDA(dst, b, h) do { _Pragma("unroll") for (int m = 0; m < 4; ++m) _Pragma("unroll") for (int k = 0; k < 2; ++k) dst[m][k] = *(const PG8_LAS bf16x8*)(lds + PG8_SA(b, h) + aoff + m * 2048 + k * 1024); } while (0)
#define PG8_LDB(dst, b, h) do { _Pragma("unroll") for (int n = 0; n < 2; ++n) _Pragma("unroll") for (int k = 0; k < 2; ++k) dst[n][k] = *(const PG8_LAS bf16x8*)(lds + PG8_SB(b, h) + boff + n * 2048 + k * 1024); } while (0)
#define PG8_MMA(ai, bj, At, Bt) do { __builtin_amdgcn_s_setprio(1); _Pragma("unroll") for (int m = 0; m < 4; ++m) _Pragma("unroll") for (int n = 0; n < 2; ++n) _Pragma("unroll") for (int k = 0; k < 2; ++k) \
        acc[ai][bj][m][n] = __builtin_amdgcn_mfma_f32_16x16x32_bf16(Bt[n][k], At[m][k], acc[ai][bj][m][n], 0, 0, 0); __builtin_amdgcn_s_setprio(0); } while (0)
#define PG8_WAIT_V(n) asm volatile("s_waitcnt vmcnt(" #n ")" ::: "memory")
#define PG8_WAIT_L(n) asm volatile("s_waitcnt lgkmcnt(" #n ")" ::: "memory")
#define PG8_BAR __builtin_amdgcn_s_barrier()
#define PG8_SCHED __builtin_amdgcn_sched_barrier(0)
    Unit cur, nxt; int ui = 0;
    if (!S.next(0, cur)) return;
    f32x4 acc[2][2][4][2];
#pragma unroll
    for (int a = 0; a < 2; ++a)
#pragma unroll
        for (int b = 0; b < 2; ++b)
#pragma unroll
            for (int m = 0; m < 4; ++m)
#pragma unroll
                for (int n = 0; n < 2; ++n) acc[a][b][m][n] = (f32x4){0.f, 0.f, 0.f, 0.f};
    bf16x8 At[4][2], B0[2][2], B1[2][2];
    const char* cA = g.pa(cur); const char* cB = g.pb(cur);
    S.a_ready(cur);
    if constexpr (SP2) {
        PG8_STAGE(PG8_SB(0, 0), cB, voffB); PG8_STAGE(PG8_SB(0, 1), cB + hstepB, voffB); PG8_STAGE(PG8_SA(0, 0), cA, voffA); PG8_STAGE(PG8_SA(0, 1), cA + hstepA, voffA);
        if (wr == 1) PG8_BAR;
        PG8_WAIT_V(2); PG8_BAR;
        PG8_STAGE(PG8_SB(1, 0), cB + kstep, voffB); PG8_STAGE(PG8_SA(1, 0), cA + kstep, voffA); PG8_STAGE(PG8_SB(1, 1), cB + hstepB + kstep, voffB);
        PG8_WAIT_V(6); PG8_BAR;
    } else {
        PG8_STAGE(PG8_SB(0, 0), cB, voffB); PG8_STAGE(PG8_SA(0, 0), cA, voffA); PG8_STAGE(PG8_SB(0, 1), cB + hstepB, voffB); PG8_STAGE(PG8_SA(0, 1), cA + hstepA, voffA);
        if (wr == 1) PG8_BAR;
        PG8_WAIT_V(4); PG8_BAR;
        PG8_STAGE(PG8_SB(1, 0), cB + kstep, voffB); PG8_STAGE(PG8_SA(1, 0), cA + kstep, voffA); PG8_STAGE(PG8_SB(1, 1), cB + hstepB + kstep, voffB);
        PG8_WAIT_V(6); PG8_BAR;
    }
    for (;;) {
        const bool has_next = S.next(ui + 1, nxt);
        const char* nA = has_next ? g.pa(nxt) : cA; const char* nB = has_next ? g.pb(nxt) : cB;
#pragma unroll 1
        for (int t = 0; t < nt; t += 2) {
            const bool last = (t == nt - 2);
            const char* a1 = cA + (size_t)(t + 1) * kstep;
            const char* a2 = last ? nA : cA + (size_t)(t + 2) * kstep; const char* b2 = last ? nB : cB + (size_t)(t + 2) * kstep;
            const char* a3 = a2 + kstep; const char* b3 = b2 + kstep;
            if (last && has_next) S.a_ready(nxt);
            if constexpr (SP2) {
            PG8_LDB(B0, 0, 0); PG8_LDB(B1, 0, 1); PG8_SCHED; PG8_LDA(At, 0, 0); PG8_STAGE(PG8_SA(1, 1), a1 + hstepA, voffA);
            PG8_WAIT_V(8); PG8_WAIT_L(0); PG8_BAR; PG8_MMA(0, 0, At, B0); PG8_MMA(0, 1, At, B1); PG8_BAR; PG8_SCHED;
            PG8_LDA(At, 0, 1); PG8_STAGE(PG8_SB(0, 0), b2, voffB); PG8_STAGE(PG8_SB(0, 1), b2 + hstepB, voffB); PG8_STAGE(PG8_SA(0, 0), a2, voffA);
            PG8_WAIT_V(8); PG8_WAIT_L(0); PG8_BAR; PG8_MMA(1, 0, At, B0); PG8_MMA(1, 1, At, B1); PG8_BAR; PG8_SCHED;
            PG8_LDB(B0, 1, 0); PG8_LDB(B1, 1, 1); PG8_SCHED; PG8_LDA(At, 1, 0); PG8_STAGE(PG8_SA(0, 1), a2 + hstepA, voffA);
            PG8_WAIT_V(8); PG8_WAIT_L(0); PG8_BAR; PG8_MMA(0, 0, At, B0); PG8_MMA(0, 1, At, B1); PG8_BAR; PG8_SCHED;
            PG8_LDA(At, 1, 1); PG8_STAGE(PG8_SB(1, 0), b3, voffB); PG8_STAGE(PG8_SB(1, 1), b3 + hstepB, voffB); PG8_STAGE(PG8_SA(1, 0), a3, voffA);
            PG8_WAIT_V(8); PG8_WAIT_L(0); PG8_BAR; PG8_MMA(1, 0, At, B0); PG8_MMA(1, 1, At, B1); PG8_BAR; PG8_SCHED;
            } else {
            PG8_LDB(B0, 0, 0); PG8_SCHED; PG8_LDA(At, 0, 0); PG8_STAGE(PG8_SA(1, 1), a1 + hstepA, voffA);
            PG8_WAIT_L(8); PG8_BAR; PG8_WAIT_L(0); PG8_MMA(0, 0, At, B0); PG8_BAR; PG8_SCHED;
            PG8_LDB(B1, 0, 1); PG8_STAGE(PG8_SB(0, 0), b2, voffB);
            PG8_BAR; PG8_WAIT_L(0); PG8_MMA(0, 1, At, B1); PG8_BAR;
            PG8_LDA(At, 0, 1); PG8_STAGE(PG8_SA(0, 0), a2, voffA);
            PG8_BAR; PG8_WAIT_L(0); PG8_MMA(1, 0, At, B0); PG8_BAR; PG8_SCHED;
            PG8_STAGE(PG8_SB(0, 1), b2 + hstepB, voffB);
            PG8_WAIT_V(6); PG8_BAR; PG8_MMA(1, 1, At, B1); PG8_BAR;
            PG8_LDB(B0, 1, 0); PG8_SCHED; PG8_LDA(At, 1, 0); PG8_STAGE(PG8_SA(0, 1), a2 + hstepA, voffA);
            PG8_WAIT_L(8); PG8_BAR; PG8_WAIT_L(0); PG8_MMA(0, 0, At, B0); PG8_BAR; PG8_SCHED;
            PG8_LDB(B1, 1, 1); PG8_STAGE(PG8_SB(1, 0), b3, voffB);
            PG8_BAR; PG8_WAIT_L(0); PG8_MMA(0, 1, At, B1); PG8_BAR;
            PG8_LDA(At, 1, 1); PG8_STAGE(PG8_SA(1, 0), a3, voffA);
            PG8_BAR; PG8_WAIT_L(0); PG8_MMA(1, 0, At, B0); PG8_BAR; PG8_SCHED;
            PG8_STAGE(PG8_SB(1, 1), b3 + hstepB, voffB);
            PG8_WAIT_V(6); PG8_BAR; PG8_MMA(1, 1, At, B1); PG8_BAR;
            }
        }
        if constexpr (ALIGN_EPI) { if (wr == 0) PG8_BAR; }
        if constexpr (!Epi::AFTER_DRAIN) { E(acc, cur, wr, wc, fr, fq); S.done(cur); }
        if (!has_next) break;
#pragma unroll
        for (int a = 0; a < 2; ++a)
#pragma unroll
            for (int b = 0; b < 2; ++b)
#pragma unroll
                for (int m = 0; m < 4; ++m)
#pragma unroll
                    for (int n = 0; n < 2; ++n) acc[a][b][m][n] = (f32x4){0.f, 0.f, 0.f, 0.f};
        cur = nxt; cA = nA; cB = nB; ++ui;
        if constexpr (ALIGN_EPI) { if (wr == 1) PG8_BAR; }
    }
    PG8_WAIT_V(0);
    if constexpr (!ALIGN_EPI) { if (wr == 0) PG8_BAR; }
    PG8_BAR;
    if constexpr (Epi::AFTER_DRAIN) { E.fused(acc, cur, wr, wc, fr, fq, lds, wid, lane); S.done(cur); }
#undef PG8_SA
#undef PG8_SB
#undef PG8_STAGE
#undef PG8_LDA
#undef PG8_LDB
#undef PG8_MMA
#undef PG8_WAIT_V
#undef PG8_WAIT_L
#undef PG8_BAR
#undef PG8_SCHED
}

}
#ifndef USE_MFMA_SC
#define USE_MFMA_SC 1
#endif
#ifndef USE_MFMA_AT
#define USE_MFMA_AT 1
#endif

constexpr int NWAVES = 8, NTHR = NWAVES * 64;
constexpr int D = 2048, BATCH = 4, SEQ = 2048, DEPTH = 4, M = BATCH * SEQ;
constexpr int INW = 6736, INWP = 6912, GW = 3 * D, N1 = INWP + GW, FF = 8192, NPJ = INWP / 256;
constexpr int O_UPOOL = 0, O_UCONV = 1024, O_CG = 2048, O_BG = 3072, O_Q = 4096, O_K = 5120, O_V = 5376, O_QI = 5632, O_KI = 6656, O_WI = 6720;
constexpr int NH = 8, HD = 128, IH = 16, IDIM = 64, TOPK = 256;
constexpr float EPS = 1e-6f;
constexpr int NPH = 10;

constexpr size_t MiB = 1u << 20;
constexpr size_t WS_CTL = 0, CTL_ZERO_BYTES = 1 * MiB;
constexpr size_t WS_WCAT1 = 1 * MiB;
constexpr size_t WS_WPOOL = 52 * MiB;
constexpr size_t WS_WBR = 53 * MiB;
constexpr size_t WS_WOUT = 65 * MiB;
constexpr size_t WS_WUP = 73 * MiB;
constexpr size_t WS_WDOWN = 105 * MiB;
constexpr size_t WS_H = 137 * MiB;
constexpr size_t WS_PROJ = 169 * MiB;
constexpr size_t WS_GATES = 277 * MiB;
constexpr size_t WS_ABUF = WS_PROJ;
constexpr size_t WS_DP = 373 * MiB;
constexpr size_t WS_Y = 389 * MiB;
constexpr size_t WS_SC = 437 * MiB;
constexpr size_t WS_MASK = 501 * MiB;
constexpr size_t WS_TMP = 503 * MiB;
constexpr size_t WS_MP = 567 * MiB;
constexpr size_t WS_MX = 599 * MiB;
constexpr size_t WS_END = 663 * MiB;
static_assert(WS_WCAT1 + (size_t)N1 * D * 2 <= WS_WPOOL && WS_PROJ + (size_t)M * INWP * 2 <= WS_GATES && WS_GATES + (size_t)M * GW * 2 <= WS_DP && WS_ABUF + (size_t)M * FF * 2 <= WS_DP, "ws map");
constexpr int CW_BAR = 4096;

constexpr int RING_OFF = 0, RING_BYTES = 131072;
constexpr int LDSCTL_OFF = RING_BYTES, MISC_OFF = LDSCTL_OFF + 320;
constexpr int LDS_BYTES = 147456;

#define GAS __attribute__((address_space(1)))
#define LAS __attribute__((address_space(3)))
typedef unsigned short bf16;
typedef unsigned v4u __attribute__((ext_vector_type(4)));
typedef unsigned v2u __attribute__((ext_vector_type(2)));
typedef float f32x4 __attribute__((ext_vector_type(4)));
#define LDS_WAIT() asm volatile("s_waitcnt lgkmcnt(0)" ::: "memory")
#define VM_WAIT() asm volatile("s_waitcnt vmcnt(0)" ::: "memory")
__device__ __forceinline__ unsigned f2bf(float f) { unsigned u = __builtin_bit_cast(unsigned, f); return (u + 0x7fffu + ((u >> 16) & 1u)) >> 16; }
__device__ __forceinline__ unsigned pk2(float lo, float hi) { return f2bf(lo) | (f2bf(hi) << 16); }
__device__ __forceinline__ float bflo(unsigned w) { return __builtin_bit_cast(float, w << 16); }
__device__ __forceinline__ float bfhi(unsigned w) { return __builtin_bit_cast(float, w & 0xffff0000u); }
__device__ __forceinline__ float bf2f(bf16 b) { return __builtin_bit_cast(float, (unsigned)b << 16); }
__device__ __forceinline__ void unpack8(const v4u w, float (&f)[8]) { f[0] = bflo(w.x); f[1] = bfhi(w.x); f[2] = bflo(w.y); f[3] = bfhi(w.y); f[4] = bflo(w.z); f[5] = bfhi(w.z); f[6] = bflo(w.w); f[7] = bfhi(w.w); }
__device__ __forceinline__ float wave_sum(float v) {
#pragma unroll
    for (int o = 1; o < 64; o <<= 1) v += __shfl_xor(v, o);
    return v;
}

#define XB_TMO      128
#define XB_XCNT(j)  (256  + 64 * (j))
#define XB_XSUB(j)  (1280 + 64 * (j))
#define XB_XGEN(j)  (2304 + 64 * (j))
#define XB_TOP      3328
#define XB_TOPGEN   3392
#define XCD_BAR_WORDS 3456
#define XB_SPIN_CAP (1u << 18)

__device__ __forceinline__ unsigned xb_ld(unsigned* p)              { return __hip_atomic_load(p, __ATOMIC_RELAXED, __HIP_MEMORY_SCOPE_AGENT); }
__device__ __forceinline__ unsigned xb_add(unsigned* p, unsigned v) { return __hip_atomic_fetch_add(p, v, __ATOMIC_RELAXED, __HIP_MEMORY_SCOPE_AGENT); }
__device__ __forceinline__ unsigned xb_xcc_id() { return (unsigned)__builtin_amdgcn_s_getreg((3 << 11) | 20) & 0xFu; }
#define XB_SPIN(cond, bar) do { unsigned _sp = 0; while (cond) { __builtin_amdgcn_s_sleep(1); \
    if ((++_sp & 255u) == 0u) { if (xb_ld(&(bar)[XB_TMO])) break; if (_sp > XB_SPIN_CAP) { atomicAdd(&(bar)[XB_TMO], 1u); break; } } } } while (0)

struct XcdBarrier {
    unsigned* bar; unsigned x;
    volatile LAS unsigned* st;
};

__device__ __forceinline__ XcdBarrier xcd_barrier_post(unsigned* bar, volatile LAS unsigned* st) {
    XcdBarrier b; b.bar = bar; b.x = xb_xcc_id(); b.st = st;
    if (threadIdx.x == 0) (void)xb_add(&bar[XB_XCNT(b.x)], 1u);
    return b;
}
__device__ __forceinline__ void xcd_barrier_complete(unsigned* bar, unsigned x, unsigned& nloc, unsigned& nx) {
    const unsigned G = gridDim.x * gridDim.y * gridDim.z;
    unsigned sum, cnt, mine, sp = 0u;
    for (;;) {
        sum = 0u; cnt = 0u; mine = 0u;
#pragma unroll
        for (unsigned j = 0; j < 16; ++j) { const unsigned c = xb_ld(&bar[XB_XCNT(j)]); sum += c; cnt += (c > 0u) ? 1u : 0u; mine = (j == x) ? c : mine; }
        if (sum == G) break;
        __builtin_amdgcn_s_sleep(1);
        if ((++sp & 255u) == 0u) { if (xb_ld(&bar[XB_TMO])) break; if (sp > XB_SPIN_CAP) { atomicAdd(&bar[XB_TMO], 1u); break; } }
    }
    nloc = mine > 0u ? mine : 1u; nx = cnt > 0u ? cnt : 1u;
}

__device__ __forceinline__ void xcd_barrier(const XcdBarrier& b) {
    asm volatile("s_waitcnt vmcnt(0)" ::: "memory");
    __syncthreads();
    if (threadIdx.x == 0) {
        unsigned* bar = b.bar;
        __builtin_amdgcn_s_waitcnt(0);
        unsigned nloc = b.st[0], nx = b.st[1];
        if (nloc == 0u) { xcd_barrier_complete(bar, b.x, nloc, nx); b.st[0] = nloc; b.st[1] = nx; }
        const unsigned old = xb_add(&bar[XB_XSUB(b.x)], 1u);
        const unsigned gen = old / nloc;
        if (old + 1u == (gen + 1u) * nloc) {
            __builtin_amdgcn_fence(__ATOMIC_RELEASE, "agent");
            asm volatile("s_waitcnt vmcnt(0)" ::: "memory");
            const unsigned og = xb_add(&bar[XB_TOP], 1u);
            const unsigned tg = og / nx;
            if (og + 1u == (tg + 1u) * nx) xb_add(&bar[XB_TOPGEN], 1u);
            else XB_SPIN(xb_ld(&bar[XB_TOPGEN]) == tg, bar);
            __builtin_amdgcn_fence(__ATOMIC_ACQUIRE, "agent");
            xb_add(&bar[XB_XGEN(b.x)], 1u);
            asm volatile("s_waitcnt vmcnt(0)" ::: "memory");
        } else {
            XB_SPIN(xb_ld(&bar[XB_XGEN(b.x)]) == gen, bar);
            __builtin_amdgcn_fence(__ATOMIC_ACQUIRE, "agent");
            asm volatile("s_waitcnt vmcnt(0)" ::: "memory");
        }
    }
    __syncthreads();
}


struct Frame {
    LAS unsigned char* lds;
    volatile LAS unsigned* MISC;
    unsigned* ctl;
    int tid, lane, wave, vcu, G;
    const float *x_in, *gains, *w_in, *pool_w, *pool_scale, *conv_w, *rel_bias, *w_branch, *w_gate, *b_gate, *w_out, *w_up, *w_down;
    float* out;
    bf16 *Wcat1, *Wpool, *Wbr, *Wout, *Wup, *Wdown;
    bf16 *Hb, *PROJ, *GATES, *ABUF, *DP, *Y, *MP;
    float *SC, *TMP, *MX;
    unsigned long long* MASK;
};

__device__ __forceinline__ void conv_item(const float* W, int K, int Nsrc, int nblk, bf16* WT, LAS float* scr, int item, int lane) {
    const int kb = item / nblk, nb = item - kb * nblk, k0 = 64 * kb, n0 = 32 * nb;
    const int nl = n0 + (lane & 31); const bool ok = nl < Nsrc;
    float wv_[32];
#pragma unroll
    for (int i = 0; i < 32; ++i) { const int kk = 2 * i + (lane >> 5); wv_[i] = ok ? __builtin_nontemporal_load(W + (size_t)(k0 + kk) * Nsrc + nl) : 0.f; }
#pragma unroll
    for (int i = 0; i < 32; ++i) { const int kk = 2 * i + (lane >> 5); scr[kk * 33 + (lane & 31)] = wv_[i]; }
    LDS_WAIT(); asm volatile("" ::: "memory");
    const int c = lane & 7;
#pragma unroll
    for (int j = 0; j < 4; ++j) { const int n = (lane >> 3) + 8 * j; const LAS float* s = scr + (8 * c) * 33 + n;
        v4u o; o.x = pk2(s[0 * 33], s[1 * 33]); o.y = pk2(s[2 * 33], s[3 * 33]); o.z = pk2(s[4 * 33], s[5 * 33]); o.w = pk2(s[6 * 33], s[7 * 33]);
        *(GAS v4u*)(WT + (size_t)(n0 + n) * K + k0 + 8 * c) = o; }
    LDS_WAIT(); asm volatile("" ::: "memory");
}
__device__ __forceinline__ void convert_weights(Frame& F, int l) {
    int lane = F.lane; asm volatile("" : "+v"(lane));
    LAS float* scr = (LAS float*)(F.lds + RING_OFF + F.wave * 16384);
    const int gw = F.vcu * NWAVES + F.wave, NGW = F.G * NWAVES;
    constexpr int I0 = 32 * 216, I1 = 32 * 192, I2 = 4 * 32, I3 = 3 * 1024, I4 = 32 * 64, I5 = 32 * 256, I6 = 128 * 64;
    constexpr int NITEMS = I0 + I1 + I2 + I3 + I4 + I5 + I6;
    for (int it = gw; it < NITEMS; it += NGW) {
        int r = it;
        if (r < I0) { conv_item(F.w_in + (size_t)l * D * INW, D, INW, 216, F.Wcat1, scr, r, lane); continue; } r -= I0;
        if (r < I1) { conv_item(F.w_gate + (size_t)l * D * GW, D, GW, 192, F.Wcat1 + (size_t)INWP * D, scr, r, lane); continue; } r -= I1;
        if (r < I2) { const int g = r >> 5; conv_item(F.pool_w + ((size_t)l * 4 + g) * 65536, 256, 256, 8, F.Wpool + (size_t)g * 65536, scr, r & 31, lane); continue; } r -= I2;
        if (r < I3) { const int n = r >> 10; conv_item(F.w_branch + ((size_t)l * 3 + n) * 1024 * D, 1024, D, 64, F.Wbr + (size_t)n * D * 1024, scr, r & 1023, lane); continue; } r -= I3;
        if (r < I4) { conv_item(F.w_out + (size_t)l * D * D, D, D, 64, F.Wout, scr, r, lane); continue; } r -= I4;
        if (r < I5) { conv_item(F.w_up + (size_t)l * D * FF, D, FF, 256, F.Wup, scr, r, lane); continue; } r -= I5;
        conv_item(F.w_down + (size_t)l * FF * D, FF, D, 64, F.Wdown, scr, r, lane);
    }
}

__device__ __forceinline__ void store_h_row(bf16* orow, const f32x4 (&v)[8], const float* g, float rstd, int lane) {
    GAS v2u* o8 = (GAS v2u*)orow;
#pragma unroll
    for (int j = 0; j < 8; ++j) { const f32x4 gv = ((const f32x4*)g)[lane + 64 * j]; v2u w; w.x = pk2(v[j].x * rstd * gv.x, v[j].y * rstd * gv.y); w.y = pk2(v[j].z * rstd * gv.z, v[j].w * rstd * gv.w); o8[lane + 64 * j] = w; }
}
__device__ __forceinline__ void norm0_phase(Frame& F, const float* x, const float* g, bf16* h) {
    int lane = F.lane; asm volatile("" : "+v"(lane));
    const int gw = F.vcu * NWAVES + F.wave, NGW = F.G * NWAVES;
    for (int row = gw; row < M; row += NGW) {
        f32x4 v[8]; float s = 0.f;
#pragma unroll
        for (int j = 0; j < 8; ++j) { v[j] = ((const f32x4*)(x + (size_t)row * D))[lane + 64 * j]; s += (v[j].x * v[j].x + v[j].y * v[j].y) + (v[j].z * v[j].z + v[j].w * v[j].w); }
        const float rstd = 1.0f / sqrtf(wave_sum(s) * (1.0f / D) + EPS);
        store_h_row(h + (size_t)row * D, v, g, rstd, lane);
    }
}
__device__ __forceinline__ void resnorm_phase(Frame& F, const float* xsrc, float* xdst, const float* mbuf, const float* g_post, const float* g_pre, bf16* h) {
    int lane = F.lane; asm volatile("" : "+v"(lane));
    const int gw = F.vcu * NWAVES + F.wave, NGW = F.G * NWAVES;
    for (int row = gw; row < M; row += NGW) {
        f32x4 mv[8], xv[8]; float s = 0.f;
#pragma unroll
        for (int j = 0; j < 8; ++j) { mv[j] = ((const f32x4*)(mbuf + (size_t)row * D))[lane + 64 * j]; xv[j] = ((const f32x4*)(xsrc + (size_t)row * D))[lane + 64 * j];
            s += (mv[j].x * mv[j].x + mv[j].y * mv[j].y) + (mv[j].z * mv[j].z + mv[j].w * mv[j].w); }
        const float rstd = 1.0f / sqrtf(wave_sum(s) * (1.0f / D) + EPS);
        float s2 = 0.f;
#pragma unroll
        for (int j = 0; j < 8; ++j) { const f32x4 gv = ((const f32x4*)g_post)[lane + 64 * j]; xv[j] = xv[j] + mv[j] * gv * rstd;
            ((f32x4*)(xdst + (size_t)row * D))[lane + 64 * j] = xv[j];
            s2 += (xv[j].x * xv[j].x + xv[j].y * xv[j].y) + (xv[j].z * xv[j].z + xv[j].w * xv[j].w); }
        if (g_pre) { const float rstd2 = 1.0f / sqrtf(wave_sum(s2) * (1.0f / D) + EPS); store_h_row(h + (size_t)row * D, xv, g_pre, rstd2, lane); }
    }
}

template <int W> __device__ __forceinline__ void pool_item(Frame& F, int row, int t, int c8) {
    float s[8], u[8];
#pragma unroll
    for (int i = 0; i < 8; ++i) s[i] = 0.f;
    v4u ld[W];
#pragma unroll
    for (int k = 0; k < W; ++k) { const int kk = (t - k) >= 0 ? k : t; ld[k] = *(const v4u*)(F.PROJ + (size_t)(row - kk) * INWP + O_UPOOL + c8); }
#pragma unroll
    for (int k = W - 1; k >= 0; --k) { unpack8(ld[k], u); const float wgt = (t - k) >= 0 ? 1.f : 0.f;
#pragma unroll
        for (int i = 0; i < 8; ++i) s[i] += wgt * u[i]; }
    const int cnt = (t + 1) < W ? (t + 1) : W;
    const float inv = 1.0f / (float)cnt;
    v4u o; o.x = pk2(s[0] * inv - u[0], s[1] * inv - u[1]); o.y = pk2(s[2] * inv - u[2], s[3] * inv - u[3]); o.z = pk2(s[4] * inv - u[4], s[5] * inv - u[5]); o.w = pk2(s[6] * inv - u[6], s[7] * inv - u[7]);
    *(v4u*)(F.DP + (size_t)row * 1024 + c8) = o;
}
__device__ __forceinline__ void poolconv_phase(Frame& F, const float* conv_w_l) {
    int tid = F.tid; asm volatile("" : "+v"(tid));
    const int gt = F.vcu * NTHR + tid, NGT = F.G * NTHR;
    for (int idx = gt; idx < M * 128; idx += NGT) {
        const int grp = idx / (M * 32), rem = idx - grp * (M * 32), row = rem >> 5, c8 = grp * 256 + (rem & 31) * 8, t = row & (SEQ - 1);
        if (grp == 0) pool_item<2>(F, row, t, c8); else if (grp == 1) pool_item<4>(F, row, t, c8); else if (grp == 2) pool_item<8>(F, row, t, c8); else pool_item<16>(F, row, t, c8);
    }
    for (int idx = gt; idx < M * 128; idx += NGT) {
        const int row = idx >> 7, c8 = (idx & 127) * 8, t = row & (SEQ - 1);
        float acc[8], a[8], b[8];
#pragma unroll
        for (int i = 0; i < 8; ++i) acc[i] = 0.f;
        v4u la[3], lb[3];
#pragma unroll
        for (int j = 0; j < 3; ++j) { const int back = (t - 2 + j) >= 0 ? (2 - j) : 0; const bf16* pr = F.PROJ + (size_t)(row - back) * INWP; la[j] = *(const v4u*)(pr + O_CG + c8); lb[j] = *(const v4u*)(pr + O_UCONV + c8); }
        const v4u lg = *(const v4u*)(F.PROJ + (size_t)row * INWP + O_BG + c8);
#pragma unroll
        for (int j = 0; j < 3; ++j) { const float wgt = (t - 2 + j) >= 0 ? 1.f : 0.f; unpack8(la[j], a); unpack8(lb[j], b);
            const f32x4 w0 = *(const f32x4*)(conv_w_l + j * 1024 + c8) * wgt, w1 = *(const f32x4*)(conv_w_l + j * 1024 + c8 + 4) * wgt;
            acc[0] += w0.x * (a[0] * b[0]); acc[1] += w0.y * (a[1] * b[1]); acc[2] += w0.z * (a[2] * b[2]); acc[3] += w0.w * (a[3] * b[3]);
            acc[4] += w1.x * (a[4] * b[4]); acc[5] += w1.y * (a[5] * b[5]); acc[6] += w1.z * (a[6] * b[6]); acc[7] += w1.w * (a[7] * b[7]); }
        unpack8(lg, a);
        v4u o; o.x = pk2(a[0] * acc[0], a[1] * acc[1]); o.y = pk2(a[2] * acc[2], a[3] * acc[3]); o.z = pk2(a[4] * acc[4], a[5] * acc[5]); o.w = pk2(a[6] * acc[6], a[7] * acc[7]);
        *(v4u*)(F.Y + (size_t)M * 1024 + (size_t)row * 1024 + c8) = o;
    }
}

__device__ __forceinline__ void scores_phase_scalar(Frame& F) {
    int tid = F.tid; asm volatile("" : "+v"(tid));
    LAS float* qs = (LAS float*)(F.lds + RING_OFF);
    LAS float* wsm = (LAS float*)(F.lds + RING_OFF + 32768);
    for (int unit = blockIdx.x; unit < M / 8; unit += F.G) {
        const int row0 = unit * 8, b = row0 / SEQ, t0 = row0 % SEQ;
        __syncthreads();
        for (int i = tid; i < 8 * 1024; i += NTHR) qs[i] = bf2f(F.PROJ[(size_t)(row0 + (i >> 10)) * INWP + O_QI + (i & 1023)]);
        if (tid < 128) wsm[tid] = bf2f(F.PROJ[(size_t)(row0 + (tid >> 4)) * INWP + O_WI + (tid & 15)]) * 0.25f;
        __syncthreads();
        for (int s = tid; s <= t0 + 7; s += NTHR) {
            float kv[64];
            const bf16* kp = F.PROJ + (size_t)(b * SEQ + s) * INWP + O_KI;
#pragma unroll
            for (int c = 0; c < 8; ++c) { float t8[8]; unpack8(*(const v4u*)(kp + 8 * c), t8);
#pragma unroll
                for (int i = 0; i < 8; ++i) kv[8 * c + i] = t8[i]; }
            for (int r = 0; r < 8; ++r) {
                float tot = 0.f;
                for (int h = 0; h < IH; ++h) {
                    float dot = 0.f; const LAS float* qp = qs + r * 1024 + h * 64;
#pragma unroll
                    for (int d = 0; d < 64; ++d) dot = fmaf(qp[d], kv[d], dot);
                    tot += wsm[r * 16 + h] * fmaxf(dot, 0.f);
                }
                if (s <= t0 + r) F.SC[(size_t)(row0 + r) * SEQ + s] = tot;
            }
        }
    }
    __syncthreads();
}

__device__ __forceinline__ unsigned fkey(float f) { const unsigned u = __builtin_bit_cast(unsigned, f); return (u & 0x80000000u) ? ~u : (u | 0x80000000u); }
__device__ __forceinline__ int wave_isum(int v) {
#pragma unroll
    for (int o = 1; o < 64; o <<= 1) v += __shfl_xor(v, o);
    return v;
}
__device__ __forceinline__ void select_phase(Frame& F) {
    int lane = F.lane; asm volatile("" : "+v"(lane));
    const int gw = F.vcu * NWAVES + F.wave, NGW = F.G * NWAVES;
    for (int row = gw; row < M; row += NGW) {
        const int t = row & (SEQ - 1);
        const float* sr = F.SC + (size_t)row * SEQ;
        unsigned key[32];
#pragma unroll
        for (int j = 0; j < 32; ++j) { const int s = 64 * j + lane; key[j] = (s <= t) ? fkey(sr[s]) : 0u; }
        unsigned long long* mr = F.MASK + (size_t)row * 32;
        if (t + 1 <= TOPK) {
#pragma unroll
            for (int j = 0; j < 32; ++j) { const unsigned long long bm = __ballot(key[j] != 0u); if (lane == 0) mr[j] = bm; }
            continue;
        }
        unsigned T = 0u; bool exact = false;
        for (int bit = 31; bit >= 0; --bit) {
            const unsigned cand = T | (1u << bit);
            int c = 0;
#pragma unroll
            for (int j = 0; j < 32; ++j) c += (key[j] >= cand) ? 1 : 0;
            c = wave_isum(c);
            if (c >= TOPK) { T = cand; if (c == TOPK) { exact = true; break; } }
        }
        if (exact) {
#pragma unroll
            for (int j = 0; j < 32; ++j) { const unsigned long long bm = __ballot(key[j] >= T); if (lane == 0) mr[j] = bm; }
            continue;
        }
        int cg = 0;
#pragma unroll
        for (int j = 0; j < 32; ++j) cg += (key[j] > T) ? 1 : 0;
        cg = wave_isum(cg);
        const int need = TOPK - cg;
        int taken = 0;
#pragma unroll
        for (int j = 0; j < 32; ++j) {
            const unsigned long long eq = __ballot(key[j] == T);
            const int rank = taken + __popcll(eq & ((1ull << lane) - 1ull));
            const bool sel = (key[j] > T) || (key[j] == T && rank < need);
            taken += __popcll(eq);
            const unsigned long long bm = __ballot(sel);
            if (lane == 0) mr[j] = bm;
        }
    }
}

__device__ __forceinline__ int t5_bucket(int dist) {
    const int n = dist > 0 ? dist : 0;
    const float nf = (float)(n > 1 ? n : 1);
    int large = 16 + (int)(logf(nf / 16.0f) / 2.0794415416798357f * 16.0f);
    large = large < 31 ? large : 31;
    return n < 16 ? n : large;
}

__device__ __forceinline__ void attn_phase_scalar(Frame& F) {
    int lane = F.lane; asm volatile("" : "+v"(lane));
    const int gw = F.vcu * NWAVES + F.wave, NGW = F.G * NWAVES;
    bf16* YA = F.Y + (size_t)2 * M * 1024;
    for (int item = gw; item < M * NH; item += NGW) {
        const int row = item >> 3, h = item & 7, g = h >> 2, b = row / SEQ, t = row % SEQ;
        const unsigned qw = *(const unsigned*)(F.PROJ + (size_t)row * INWP + O_Q + h * HD + 2 * lane);
        const float q0 = bflo(qw), q1 = bfhi(qw);
        const unsigned long long* mr = F.MASK + (size_t)row * 32;
        float mx = -INFINITY, l = 0.f, o0 = 0.f, o1 = 0.f;
        const float scale = 0.08838834764831845f;
        for (int j = 0; j <= (t >> 6); ++j) {
            unsigned long long w = mr[j];
            while (w) {
                const int bpos = __ffsll((long long)w) - 1; w &= w - 1;
                const int s = 64 * j + bpos;
                if (s > t) continue;
                const bf16* kr = F.PROJ + (size_t)(b * SEQ + s) * INWP;
                const unsigned kw = *(const unsigned*)(kr + O_K + g * HD + 2 * lane), vw = *(const unsigned*)(kr + O_V + g * HD + 2 * lane);
                const float dot = wave_sum(q0 * bflo(kw) + q1 * bfhi(kw));
                const float logit = dot * scale + F.rel_bias[t5_bucket(t - s) * NH + h];
                const float nm = fmaxf(mx, logit);
                const float corr = __expf(mx - nm), p = __expf(logit - nm);
                l = l * corr + p; o0 = o0 * corr + p * bflo(vw); o1 = o1 * corr + p * bfhi(vw);
                mx = nm;
            }
        }
        const float inv = 1.0f / l;
        *(unsigned*)(YA + (size_t)row * 1024 + h * HD + 2 * lane) = pk2(o0 * inv, o1 * inv);
    }
}


typedef short bf16x8 __attribute__((ext_vector_type(8)));
typedef float f32x16 __attribute__((ext_vector_type(16)));
__device__ __forceinline__ void scores_phase_mfma(Frame& F) {
    int lane = F.lane; asm volatile("" : "+v"(lane));
    const int c = lane & 15, q4 = lane >> 4, wave = F.wave;
    for (int rep = 0; rep < 2; ++rep) {
        const int j = blockIdx.x, b = j >> 6, i = j & 63, tb = rep == 0 ? 127 - i : i, t0 = tb * 16, nt = tb + 1;
        const bf16* qrow = F.PROJ + (size_t)(b * SEQ + t0 + c) * INWP + O_QI + 8 * q4;
        bf16x8 qa[16][2];
#pragma unroll
        for (int h = 0; h < 16; ++h)
#pragma unroll
            for (int ks = 0; ks < 2; ++ks) qa[h][ks] = *(const bf16x8*)(qrow + h * 64 + 32 * ks);
        float wv[4][16];
#pragma unroll
        for (int r = 0; r < 4; ++r) { const bf16* wp = F.PROJ + (size_t)(b * SEQ + t0 + 4 * q4 + r) * INWP + O_WI; float t8[8];
            unpack8(*(const v4u*)wp, t8);
#pragma unroll
            for (int k = 0; k < 8; ++k) wv[r][k] = t8[k];
            unpack8(*(const v4u*)(wp + 8), t8);
#pragma unroll
            for (int k = 0; k < 8; ++k) wv[r][8 + k] = t8[k]; }
        const bf16* kbase = F.PROJ + (size_t)(b * SEQ + c) * INWP + O_KI + 8 * q4;
        float* srow = F.SC + (size_t)(b * SEQ + t0 + 4 * q4) * SEQ + c;
        bf16x8 kb0, kb1;
        if (wave < nt) { const bf16* kp = kbase + (size_t)(wave * 16) * INWP; kb0 = *(const bf16x8*)kp; kb1 = *(const bf16x8*)(kp + 32); }
        for (int kt = wave; kt < nt; kt += NWAVES) {
            const bf16x8 b0 = kb0, b1 = kb1;
            if (kt + NWAVES < nt) { const bf16* kp = kbase + (size_t)((kt + NWAVES) * 16) * INWP; kb0 = *(const bf16x8*)kp; kb1 = *(const bf16x8*)(kp + 32); }
            f32x4 tot = {0.f, 0.f, 0.f, 0.f};
#pragma unroll
            for (int h = 0; h < 16; ++h) {
                f32x4 acc = {0.f, 0.f, 0.f, 0.f};
                acc = __builtin_amdgcn_mfma_f32_16x16x32_bf16(qa[h][0], b0, acc, 0, 0, 0);
                acc = __builtin_amdgcn_mfma_f32_16x16x32_bf16(qa[h][1], b1, acc, 0, 0, 0);
#pragma unroll
                for (int r = 0; r < 4; ++r) tot[r] += wv[r][h] * fmaxf(acc[r], 0.f);
            }
#pragma unroll
            for (int r = 0; r < 4; ++r) srow[(size_t)r * SEQ + kt * 16] = tot[r];
        }
    }
}

constexpr int AT_KPITCH = 272, AT_VPITCH = 72;
constexpr int AT_KBUF = 0, AT_VBUF = 2 * 32 * AT_KPITCH, AT_LUT = AT_VBUF + 2 * 128 * AT_VPITCH, AT_MERGE = 40960, AT_END = AT_MERGE + 4 * 66 * 64 * 4;
static_assert(AT_LUT + 8 * 132 * 4 <= AT_MERGE && AT_END <= RING_BYTES, "attention LDS map");
__device__ __forceinline__ void attn_phase_mfma(Frame& F) {
    int tid = F.tid; asm volatile("" : "+v"(tid));
    const int lane = tid & 63, wave = F.wave, grp = wave >> 2, hr = wave & 3, c = lane & 31, hh = lane >> 5, tg = tid & 255;
    LAS unsigned char* KB = F.lds + RING_OFF + AT_KBUF + grp * (32 * AT_KPITCH);
    LAS unsigned char* VB = F.lds + RING_OFF + AT_VBUF + grp * (128 * AT_VPITCH);
    LAS float* LUT = (LAS float*)(F.lds + RING_OFF + AT_LUT);
    LAS float* MG = (LAS float*)(F.lds + RING_OFF + AT_MERGE) + hr * (66 * 64);
    const float LOG2E = 1.4426950408889634f, C1 = 0.08838834764831845f * 1.4426950408889634f;
    __syncthreads();
    for (int idx = tid; idx < 8 * 129; idx += NTHR) { const int hd = idx / 129, d = idx - hd * 129; LUT[hd * 132 + d] = F.rel_bias[t5_bucket(d) * NH + hd] * LOG2E; }
    __syncthreads();
    bf16* YA = F.Y + (size_t)2 * M * 1024;
    const unsigned* maskw = (const unsigned*)F.MASK;
    for (int rep = 0; rep < 2; ++rep) {
        const int j = blockIdx.x, bg = j >> 5, i = j & 31, qb = rep == 0 ? 63 - i : i, b = bg >> 1, g = bg & 1, h = 4 * g + hr;
        const int q0 = qb * 32, tq = q0 + c; const size_t row_q = (size_t)(b * SEQ + tq);
        bf16x8 qf[8];
#pragma unroll
        for (int ks = 0; ks < 8; ++ks) qf[ks] = *(const bf16x8*)(F.PROJ + row_q * INWP + O_Q + h * HD + 16 * ks + 8 * hh);
        f32x16 o[4];
#pragma unroll
        for (int db = 0; db < 4; ++db)
#pragma unroll
            for (int r = 0; r < 16; ++r) o[db][r] = 0.f;
        float m = -INFINITY, l = 0.f;
        const int nsteps = (qb + 2) >> 1;
        const bf16* kvb = F.PROJ + (size_t)(b * SEQ) * INWP + g * HD;
        v4u sk[2], sv[2];
        {
            const int kt = grp;
            if (kt <= qb) {
#pragma unroll
                for (int u = 0; u < 2; ++u) { const int ck = tg + 256 * u; sk[u] = *(const v4u*)(kvb + (size_t)(kt * 32 + (ck >> 4)) * INWP + O_K + (ck & 15) * 8); }
#pragma unroll
                for (int u = 0; u < 2; ++u) sv[u] = *(const v4u*)(kvb + (size_t)(kt * 32 + 2 * (tg & 15) + u) * INWP + O_V + (tg >> 4) * 8);
            }
        }
        for (int st = 0; st < nsteps; ++st) {
            const int kt = 2 * st + grp; const bool valid = kt <= qb;
            if (valid) {
#pragma unroll
                for (int u = 0; u < 2; ++u) { const int ck = tg + 256 * u; *(LAS v4u*)(KB + (ck >> 4) * AT_KPITCH + (ck & 15) * 16) = sk[u]; }
                const int kp = tg & 15, dc = tg >> 4;
                const unsigned a0[4] = {sv[0].x, sv[0].y, sv[0].z, sv[0].w}, a1[4] = {sv[1].x, sv[1].y, sv[1].z, sv[1].w};
#pragma unroll
                for (int e = 0; e < 4; ++e) {
                    *(LAS unsigned*)(VB + (dc * 8 + 2 * e) * AT_VPITCH + kp * 4) = (a0[e] & 0xffffu) | (a1[e] << 16);
                    *(LAS unsigned*)(VB + (dc * 8 + 2 * e + 1) * AT_VPITCH + kp * 4) = (a0[e] >> 16) | (a1[e] & 0xffff0000u);
                }
            }
            __syncthreads();
            unsigned mw = 0u;
            if (valid) mw = maskw[row_q * 64 + kt];
            {
                const int ktn = kt + 2;
                if (ktn <= qb) {
#pragma unroll
                    for (int u = 0; u < 2; ++u) { const int ck = tg + 256 * u; sk[u] = *(const v4u*)(kvb + (size_t)(ktn * 32 + (ck >> 4)) * INWP + O_K + (ck & 15) * 8); }
#pragma unroll
                    for (int u = 0; u < 2; ++u) sv[u] = *(const v4u*)(kvb + (size_t)(ktn * 32 + 2 * (tg & 15) + u) * INWP + O_V + (tg >> 4) * 8);
                }
            }
            if (valid) {
                const int key0 = kt * 32;
                f32x16 s;
#pragma unroll
                for (int r = 0; r < 16; ++r) s[r] = 0.f;
#pragma unroll
                for (int ks = 0; ks < 8; ++ks) { const bf16x8 a = *(const LAS bf16x8*)(KB + c * AT_KPITCH + (16 * ks + 8 * hh) * 2); s = __builtin_amdgcn_mfma_f32_32x32x16_bf16(a, qf[ks], s, 0, 0, 0); }
                const bool far = (q0 - key0 - 31) >= 128;
                const float bfar = LUT[h * 132 + 128];
                float tmax = -INFINITY;
#pragma unroll
                for (int r = 0; r < 16; ++r) {
                    const int koff = (r & 3) + 8 * (r >> 2) + 4 * hh;
                    float bias = bfar;
                    if (!far) { int dist = tq - (key0 + koff); dist = dist < 0 ? 0 : (dist > 128 ? 128 : dist); bias = LUT[h * 132 + dist]; }
                    const float v = ((mw >> koff) & 1u) ? (s[r] * C1 + bias) : -INFINITY;
                    s[r] = v; tmax = fmaxf(tmax, v);
                }
                tmax = fmaxf(tmax, __shfl_xor(tmax, 32));
                const float mn = fmaxf(m, tmax), ms = (mn == -INFINITY) ? 0.f : mn;
                const float corr = __builtin_amdgcn_exp2f(m - ms);
                float rs = 0.f;
#pragma unroll
                for (int r = 0; r < 16; ++r) { const float p = __builtin_amdgcn_exp2f(s[r] - ms); s[r] = p; rs += p; }
                l = l * corr + rs; m = mn;
#pragma unroll
                for (int db = 0; db < 4; ++db)
#pragma unroll
                    for (int r = 0; r < 16; ++r) o[db][r] *= corr;
                bf16x8 pf[2];
#pragma unroll
                for (int s2 = 0; s2 < 2; ++s2) { v4u w; w.x = pg8::cvt_pk_bf16(s[8 * s2 + 0], s[8 * s2 + 1]); w.y = pg8::cvt_pk_bf16(s[8 * s2 + 2], s[8 * s2 + 3]); w.z = pg8::cvt_pk_bf16(s[8 * s2 + 4], s[8 * s2 + 5]); w.w = pg8::cvt_pk_bf16(s[8 * s2 + 6], s[8 * s2 + 7]); pf[s2] = __builtin_bit_cast(bf16x8, w); }
#pragma unroll
                for (int db = 0; db < 4; ++db)
#pragma unroll
                    for (int s2 = 0; s2 < 2; ++s2) {
                        const LAS unsigned char* vp = VB + (32 * db + c) * AT_VPITCH + (16 * s2 + 4 * hh) * 2;
                        const v2u lo = *(const LAS v2u*)vp, hi = *(const LAS v2u*)(vp + 16);
                        v4u w; w.x = lo.x; w.y = lo.y; w.z = hi.x; w.w = hi.y;
                        o[db] = __builtin_amdgcn_mfma_f32_32x32x16_bf16(__builtin_bit_cast(bf16x8, w), pf[s2], o[db], 0, 0, 0);
                    }
            }
            __syncthreads();
        }
        if (grp == 1) {
#pragma unroll
            for (int db = 0; db < 4; ++db)
#pragma unroll
                for (int r = 0; r < 16; ++r) MG[(db * 16 + r) * 64 + lane] = o[db][r];
            MG[64 * 64 + lane] = m; MG[65 * 64 + lane] = l;
        }
        __syncthreads();
        if (grp == 0) {
            const float m2 = MG[64 * 64 + lane], l2 = MG[65 * 64 + lane];
            const float mn = fmaxf(m, m2), ms = (mn == -INFINITY) ? 0.f : mn;
            const float fa = __builtin_amdgcn_exp2f(m - ms), fb = __builtin_amdgcn_exp2f(m2 - ms);
            float lt = l * fa + l2 * fb; lt += __shfl_xor(lt, 32);
            const float inv = 1.0f / lt;
            bf16* yp = YA + row_q * 1024 + h * HD + 4 * hh;
#pragma unroll
            for (int db = 0; db < 4; ++db)
#pragma unroll
                for (int rg = 0; rg < 4; ++rg) {
                    float v[4];
#pragma unroll
                    for (int e = 0; e < 4; ++e) v[e] = (o[db][4 * rg + e] * fa + MG[(db * 16 + 4 * rg + e) * 64 + lane] * fb) * inv;
                    v2u w; w.x = pg8::cvt_pk_bf16(v[0], v[1]); w.y = pg8::cvt_pk_bf16(v[2], v[3]);
                    *(v2u*)(yp + 32 * db + 8 * rg) = w;
                }
        }
        __syncthreads();
    }
}

struct Args { const float* in[13]; float* out; unsigned char* ws; int ph_lo, ph_hi; };
__global__ void __launch_bounds__(NTHR, 2) mk_fwd(Args args) {
    extern __shared__ __attribute__((aligned(16))) unsigned char lds[];
    Frame F;
    F.lds = (LAS unsigned char*)lds;
    F.MISC = (volatile LAS unsigned*)(F.lds + MISC_OFF);
    F.tid = threadIdx.x; F.lane = F.tid & 63; F.wave = __builtin_amdgcn_readfirstlane(F.tid >> 6);
    F.G = gridDim.x; { const int bx = blockIdx.x; F.vcu = (F.G % 8 == 0) ? (bx % 8) * (F.G / 8) + bx / 8 : bx; }
    unsigned char* ws = args.ws;
    F.ctl = (unsigned*)(ws + WS_CTL);
    F.x_in = args.in[0]; F.gains = args.in[1]; F.w_in = args.in[2]; F.pool_w = args.in[3]; F.pool_scale = args.in[4]; F.conv_w = args.in[5]; F.rel_bias = args.in[6];
    F.w_branch = args.in[7]; F.w_gate = args.in[8]; F.b_gate = args.in[9]; F.w_out = args.in[10]; F.w_up = args.in[11]; F.w_down = args.in[12]; F.out = args.out;
    F.Wcat1 = (bf16*)(ws + WS_WCAT1); F.Wpool = (bf16*)(ws + WS_WPOOL); F.Wbr = (bf16*)(ws + WS_WBR); F.Wout = (bf16*)(ws + WS_WOUT); F.Wup = (bf16*)(ws + WS_WUP); F.Wdown = (bf16*)(ws + WS_WDOWN);
    F.Hb = (bf16*)(ws + WS_H); F.PROJ = (bf16*)(ws + WS_PROJ); F.GATES = (bf16*)(ws + WS_GATES); F.ABUF = (bf16*)(ws + WS_ABUF); F.DP = (bf16*)(ws + WS_DP); F.Y = (bf16*)(ws + WS_Y); F.MP = (bf16*)(ws + WS_MP);
    F.SC = (float*)(ws + WS_SC); F.TMP = (float*)(ws + WS_TMP); F.MX = (float*)(ws + WS_MX); F.MASK = (unsigned long long*)(ws + WS_MASK);
    for (int u = F.tid; u < (LDS_BYTES - LDSCTL_OFF) / 4; u += NTHR) ((LAS unsigned*)(F.lds + LDSCTL_OFF))[u] = 0u;
    __syncthreads();
    XcdBarrier bar; bar.bar = F.ctl + CW_BAR; bar.x = 0; bar.st = nullptr;
    if (!MK_SPLIT) bar = xcd_barrier_post(F.ctl + CW_BAR, F.MISC + 8);
#define GRID_BAR() do { if (!MK_SPLIT) xcd_barrier(bar); } while (0)
    const int lo = args.ph_lo, hi = args.ph_hi;
#define IN(k) (lo <= (k) && (k) < hi)
    LAS unsigned char* ring = F.lds + RING_OFF;

    if (IN(0)) { convert_weights(F, 0); norm0_phase(F, F.x_in, F.gains, F.Hb); GRID_BAR(); }

    for (int l = 0; l < DEPTH; ++l) {
        const int pb = 1 + l * NPH;
        const float* g = F.gains + (size_t)l * 4 * D;
        if (IN(pb + 0)) {
            pg8::Gemm gm{F.Hb, F.Wcat1, D, D, D, 0, 0, 0}; pg8::StaticOrder S; S.init(M, N1, F.G, (int)blockIdx.x);
            pg8::EpiProjGate E{F.PROJ, INWP, F.GATES, GW, F.b_gate + (size_t)l * GW, NPJ};
            pg8::gemm_phase<pg8::EpiProjGate, pg8::StaticOrder, true, true>(ring, gm, S, E);
            GRID_BAR();
        }
        if (IN(pb + 1)) { poolconv_phase(F, F.conv_w + (size_t)l * 3 * 1024); if (USE_MFMA_SC) scores_phase_mfma(F); else scores_phase_scalar(F); GRID_BAR(); }
        if (IN(pb + 2)) {
            pg8::Gemm gm{F.DP, F.Wpool, 1024, 256, 256, 256, 0, 0}; pg8::StaticOrder S; S.init(M, 1024, F.G, (int)blockIdx.x);
            pg8::EpiBf16<2> E{F.Y, 1024, F.pool_scale + (size_t)l * 1024};
            pg8::gemm_phase<pg8::EpiBf16<2>, pg8::StaticOrder, true, true>(ring, gm, S, E);
            select_phase(F);
            GRID_BAR();
        }
        if (IN(pb + 3)) { if (USE_MFMA_AT) attn_phase_mfma(F); else attn_phase_scalar(F); GRID_BAR(); }
        if (IN(pb + 4)) {
            pg8::Gemm gm{F.Y, F.Wbr, 1024, 1024, 1024, 0, (long)M * 1024, (long)D * 1024}; pg8::StaticOrder S; S.init(M, D, F.G, (int)blockIdx.x, 3);
            pg8::EpiBranch E{F.GATES, GW, D, F.TMP, F.MP, D, 3};
            pg8::gemm_phase<pg8::EpiBranch, pg8::StaticOrder, true, true>(ring, gm, S, E);
            GRID_BAR();
        }
        if (IN(pb + 5)) {
            pg8::Gemm gm{F.MP, F.Wout, D, D, D, 0, 0, 0}; pg8::StaticOrder S; S.init(M, D, F.G, (int)blockIdx.x);
            pg8::EpiF32 E{F.MX, D};
            pg8::gemm_phase<pg8::EpiF32, pg8::StaticOrder, true, true>(ring, gm, S, E);
            GRID_BAR();
        }
        if (IN(pb + 6)) { resnorm_phase(F, l == 0 ? F.x_in : F.out, F.out, F.MX, g + D, g + 2 * D, F.Hb); GRID_BAR(); }
        if (IN(pb + 7)) {
            pg8::Gemm gm{F.Hb, F.Wup, D, D, D, 0, 0, 0}; pg8::StaticOrder S; S.init(M, FF, F.G, (int)blockIdx.x);
            pg8::EpiBf16<1> E{F.ABUF, FF, nullptr};
            pg8::gemm_phase<pg8::EpiBf16<1>, pg8::StaticOrder, true, true>(ring, gm, S, E);
            GRID_BAR();
        }
        if (IN(pb + 8)) {
            pg8::Gemm gm{F.ABUF, F.Wdown, FF, FF, FF, 0, 0, 0}; pg8::StaticOrder S; S.init(M, D, F.G, (int)blockIdx.x);
            pg8::EpiF32 E{F.MX, D};
            pg8::gemm_phase<pg8::EpiF32, pg8::StaticOrder, true, true>(ring, gm, S, E);
            GRID_BAR();
        }
        if (IN(pb + 9)) {
            if (l + 1 < DEPTH) { convert_weights(F, l + 1); resnorm_phase(F, F.out, F.out, F.MX, g + 3 * D, g + 4 * D, F.Hb); GRID_BAR(); }
            else resnorm_phase(F, F.out, F.out, F.MX, g + 3 * D, nullptr, nullptr);
        }
    }
#undef IN
#undef GRID_BAR
}

extern "C" void kernel_launch(void* const* d_in, const int* in_sizes, int n_in, void* d_out, int out_size, void* d_ws, size_t ws_size, hipStream_t stream) {
    static int grid = 0;
    if (grid == 0) {
        if (n_in != 13 || out_size != M * D || ws_size < WS_END) { fprintf(stderr, "kernel_launch: unexpected shapes (n_in %d out %d ws %zu need %zu); nothing launched\n", n_in, out_size, ws_size, (size_t)WS_END); grid = -1; return; }
        int dev = 0, cus = 0, per_cu = 0;
        if (hipGetDevice(&dev) != hipSuccess || hipDeviceGetAttribute(&cus, hipDeviceAttributeMultiprocessorCount, dev) != hipSuccess) { grid = -1; return; }
        if (hipFuncSetAttribute((const void*)mk_fwd, hipFuncAttributeMaxDynamicSharedMemorySize, LDS_BYTES) != hipSuccess) { fprintf(stderr, "kernel_launch: hipFuncSetAttribute failed\n"); grid = -1; return; }
        if (hipOccupancyMaxActiveBlocksPerMultiprocessor(&per_cu, (const void*)mk_fwd, NTHR, LDS_BYTES) != hipSuccess || per_cu < 1) { fprintf(stderr, "kernel_launch: occupancy query says %d\n", per_cu); }
        (void)hipGetLastError();
        grid = cus;
    }
    if (grid < 0) return;
    if (hipMemsetAsync((char*)d_ws + WS_CTL, 0, CTL_ZERO_BYTES, stream) != hipSuccess) return;
    Args a{};
    for (int i = 0; i < 13; ++i) a.in[i] = (const float*)d_in[i];
    a.out = (float*)d_out; a.ws = (unsigned char*)d_ws;
#if MK_SPLIT
    for (int p = 0; p < 1 + DEPTH * NPH; ++p) { a.ph_lo = p; a.ph_hi = p + 1; hipLaunchKernelGGL(mk_fwd, dim3(grid), dim3(NTHR), LDS_BYTES, stream, a); }
#else
    a.ph_lo = 0; a.ph_hi = 1 << 20;
    hipLaunchKernelGGL(mk_fwd, dim3(grid), dim3(NTHR), LDS_BYTES, stream, a);
#endif
}
```

```cpp
#include <hip/hip_runtime.h>
#include <cstdio>
#include <cstdint>

#ifndef MK_SPLIT
#define MK_SPLIT 0
#endif

namespace pg8 {
#define PG8_LAS __attribute__((address_space(3)))
typedef unsigned short bf16_t;
typedef short bf16x8 __attribute__((ext_vector_type(8)));
typedef float f32x4 __attribute__((ext_vector_type(4)));
typedef float f32x2 __attribute__((ext_vector_type(2)));
typedef unsigned u32x4 __attribute__((ext_vector_type(4)));
constexpr int BM = 256, BK = 64, HALF = 128, HTB = HALF * BK * 2  , STAGE_BYTES = 8 * HTB, NXCD = 8, WGM = 8;

__host__ __device__ __forceinline__ int lds_byte(int r, int c) { const int st = (r >> 4) * 2 + (c >> 5), rr = r & 15, cc = c & 31, ob = rr * 64 + cc * 2; return st * 1024 + (ob ^ (((ob >> 9) & 1) << 5)); }
__host__ __device__ __forceinline__ void stage_rc(int b, int& R, int& C) { const int st = b / 1024, sb = b % 1024, swz = sb ^ (((sb >> 9) & 1) << 5); R = (st >> 1) * 16 + swz / 64; C = (st & 1) * 32 + (swz % 64) / 2; }
__host__ __device__ __forceinline__ int perm32(int rho) { const int n = rho >> 4, i = rho & 15; return 8 * (i >> 2) + 4 * n + (i & 3); }

struct Unit { int pm, pn, sub; };
struct Gemm {
    const bf16_t* A; const bf16_t* Bt; int lda, ldb, K; long a_pn, a_sub, b_sub;
    __device__ __forceinline__ const char* pa(const Unit& u) const { return (const char*)(A + ((size_t)u.pm * BM * lda + (size_t)u.pn * a_pn + (size_t)u.sub * a_sub)); }
    __device__ __forceinline__ const char* pb(const Unit& u) const { return (const char*)(Bt + ((size_t)u.pn * BM * ldb + (size_t)u.sub * b_sub)); }
};

struct StaticOrder {
    int nM, nN, nwg, G, c, subs;
    __host__ __device__ void init(int M, int N, int G_, int c_, int subs_ = 1) { nM = M / BM; nN = N / BM; nwg = nM * nN; G = G_; c = c_; subs = subs_; }
    __host__ __device__ bool next(int i, Unit& u) const {
        const int ti = i / subs;
        const long L = (long)ti * G + c; if (L >= nwg) return false;
        int wgid = (int)L; { const int q = nwg / NXCD, r = nwg % NXCD, xcd = wgid % NXCD, off = wgid / NXCD; wgid = (xcd < r ? xcd * (q + 1) : r * (q + 1) + (xcd - r) * q) + off; }
        const int nig = WGM * nN, gid = wgid / nig, fm = gid * WGM, gsz = (nM - fm) < WGM ? (nM - fm) : WGM;
        u.pm = fm + ((wgid % nig) % gsz); u.pn = (wgid % nig) / gsz; u.sub = i - ti * subs; return true;
    }
    __device__ __forceinline__ void a_ready(const Unit&) const {}
    __device__ __forceinline__ void done(const Unit&) const {}
};

typedef __bf16 bf16x2_t __attribute__((ext_vector_type(2)));
__device__ __forceinline__ unsigned cvt_pk_bf16(float lo, float hi) { const f32x2 v = {lo, hi}; return __builtin_bit_cast(unsigned, __builtin_convertvector(v, bf16x2_t)); }
__device__ __forceinline__ float bflo(unsigned w) { return __builtin_bit_cast(float, w << 16); }
__device__ __forceinline__ float bfhi(unsigned w) { return __builtin_bit_cast(float, w & 0xffff0000u); }
__device__ __forceinline__ u32x4 pack8(const f32x4& v0, const f32x4& v1) { u32x4 w; w.x = cvt_pk_bf16(v0[0], v0[1]); w.y = cvt_pk_bf16(v0[2], v0[3]); w.z = cvt_pk_bf16(v1[0], v1[1]); w.w = cvt_pk_bf16(v1[2], v1[3]); return w; }

struct EpiF32 {
    static constexpr bool PERM = false, AFTER_DRAIN = false;
    float* C; int ldc;
    __device__ __forceinline__ void operator()(const f32x4 (&acc)[2][2][4][2], const Unit& u, int wr, int wc, int fr_, int fq_) const {
        int fr = fr_, fq = fq_; asm volatile("" : "+v"(fr), "+v"(fq));
        const int row0 = u.pm * BM + wr * 64 + fr, col0 = u.pn * BM + wc * 32 + 4 * fq;
#pragma unroll
        for (int ai = 0; ai < 2; ++ai)
#pragma unroll
            for (int m = 0; m < 4; ++m) { float* rowp = C + (size_t)(row0 + ai * HALF + m * 16) * ldc + col0;
#pragma unroll
                for (int bj = 0; bj < 2; ++bj)
#pragma unroll
                    for (int n = 0; n < 2; ++n) *(f32x4*)(rowp + bj * HALF + n * 16) = acc[ai][bj][m][n]; }
    }
};
template <int ACT> struct EpiBf16 {
    static constexpr bool PERM = true, AFTER_DRAIN = false;
    bf16_t* O; int ldc; const float* vec;
    __device__ __forceinline__ void operator()(const f32x4 (&acc)[2][2][4][2], const Unit& u, int wr, int wc, int fr_, int fq_) const {
        int fr = fr_, fq = fq_; asm volatile("" : "+v"(fr), "+v"(fq));
        const int row0 = u.pm * BM + wr * 64 + fr, col0 = u.pn * BM + wc * 32 + 8 * fq;
        f32x4 sv[2][2];
        if (ACT == 2) {
#pragma unroll
            for (int bj = 0; bj < 2; ++bj)
#pragma unroll
                for (int n = 0; n < 2; ++n) sv[bj][n] = *(const f32x4*)(vec + col0 + bj * HALF + 4 * n);
        }
#pragma unroll
        for (int ai = 0; ai < 2; ++ai)
#pragma unroll
            for (int m = 0; m < 4; ++m) { bf16_t* rowp = O + (size_t)(row0 + ai * HALF + m * 16) * ldc + col0;
#pragma unroll
                for (int bj = 0; bj < 2; ++bj) { f32x4 v0 = acc[ai][bj][m][0], v1 = acc[ai][bj][m][1];
                    if (ACT == 1) {
#pragma unroll
                        for (int j = 0; j < 4; ++j) { const float a = fmaxf(v0[j], 0.f), b = fmaxf(v1[j], 0.f); v0[j] = a * a; v1[j] = b * b; } }
                    if (ACT == 2) { v0 = v0 * sv[bj][0]; v1 = v1 * sv[bj][1]; }
                    *(u32x4*)(rowp + bj * HALF) = pack8(v0, v1); } }
    }
};
struct EpiProjGate {
    static constexpr bool PERM = true, AFTER_DRAIN = false;
    bf16_t* P; int ldp; bf16_t* Gt; int ldg; const float* bias; int npj;
    __device__ __forceinline__ void operator()(const f32x4 (&acc)[2][2][4][2], const Unit& u, int wr, int wc, int fr_, int fq_) const {
        int fr = fr_, fq = fq_; asm volatile("" : "+v"(fr), "+v"(fq));
        const int row0 = u.pm * BM + wr * 64 + fr;
        if (u.pn < npj) {
            const int col0 = u.pn * BM + wc * 32 + 8 * fq;
#pragma unroll
            for (int ai = 0; ai < 2; ++ai)
#pragma unroll
                for (int m = 0; m < 4; ++m) { bf16_t* rowp = P + (size_t)(row0 + ai * HALF + m * 16) * ldp + col0;
#pragma unroll
                    for (int bj = 0; bj < 2; ++bj) *(u32x4*)(rowp + bj * HALF) = pack8(acc[ai][bj][m][0], acc[ai][bj][m][1]); }
        } else {
            const int col0 = (u.pn - npj) * BM + wc * 32 + 8 * fq;
            f32x4 bv[2][2];
#pragma unroll
            for (int bj = 0; bj < 2; ++bj)
#pragma unroll
                for (int n = 0; n < 2; ++n) bv[bj][n] = *(const f32x4*)(bias + col0 + bj * HALF + 4 * n);
#pragma unroll
            for (int ai = 0; ai < 2; ++ai)
#pragma unroll
                for (int m = 0; m < 4; ++m) { bf16_t* rowp = Gt + (size_t)(row0 + ai * HALF + m * 16) * ldg + col0;
#pragma unroll
                    for (int bj = 0; bj < 2; ++bj) { f32x4 v0 = acc[ai][bj][m][0] + bv[bj][0], v1 = acc[ai][bj][m][1] + bv[bj][1];
#pragma unroll
                        for (int j = 0; j < 4; ++j) { v0[j] = __builtin_amdgcn_rcpf(1.0f + __expf(-v0[j])); v1[j] = __builtin_amdgcn_rcpf(1.0f + __expf(-v1[j])); }
                        *(u32x4*)(rowp + bj * HALF) = pack8(v0, v1); } }
        }
    }
};
struct EpiBranch {
    static constexpr bool PERM = true, AFTER_DRAIN = false;
    const bf16_t* Gt; int ldg; int gsub; float* tmp; bf16_t* O; int ldc; int nsub;
    __device__ __forceinline__ void operator()(f32x4 (&acc)[2][2][4][2], const Unit& u, int wr, int wc, int fr_, int fq_) const {
        int fr = fr_, fq = fq_; asm volatile("" : "+v"(fr), "+v"(fq));
        const int row0 = u.pm * BM + wr * 64 + fr, col0 = u.pn * BM + wc * 32 + 8 * fq;
        const bool first = u.sub == 0, last = u.sub == nsub - 1;
#pragma unroll
        for (int ai = 0; ai < 2; ++ai)
#pragma unroll
        for (int mh = 0; mh < 2; ++mh) {
            u32x4 gw[2][2]; f32x4 t0[2][2], t1[2][2];
#pragma unroll
            for (int mm = 0; mm < 2; ++mm) { const size_t r = (size_t)(row0 + ai * HALF + (2 * mh + mm) * 16);
#pragma unroll
                for (int bj = 0; bj < 2; ++bj) { const int c = col0 + bj * HALF;
                    gw[mm][bj] = *(const u32x4*)(Gt + r * ldg + (size_t)u.sub * gsub + c);
                    if (!first) { const float* tp = tmp + r * ldc + c; t0[mm][bj] = *(const f32x4*)tp; t1[mm][bj] = *(const f32x4*)(tp + 4); } } }
#pragma unroll
            for (int mm = 0; mm < 2; ++mm) { const int m = 2 * mh + mm; const size_t r = (size_t)(row0 + ai * HALF + m * 16);
#pragma unroll
                for (int bj = 0; bj < 2; ++bj) { const int c = col0 + bj * HALF; const u32x4 g = gw[mm][bj];
                    f32x4 v0 = acc[ai][bj][m][0], v1 = acc[ai][bj][m][1];
                    v0[0] *= bflo(g.x); v0[1] *= bfhi(g.x); v0[2] *= bflo(g.y); v0[3] *= bfhi(g.y);
                    v1[0] *= bflo(g.z); v1[1] *= bfhi(g.z); v1[2] *= bflo(g.w); v1[3] *= bfhi(g.w);
                    if (!first) { v0 = v0 + t0[mm][bj]; v1 = v1 + t1[mm][bj]; }
                    float* tp = tmp + r * ldc + c;
                    if (!last) { *(f32x4*)tp = v0; *(f32x4*)(tp + 4) = v1; }
                    else *(u32x4*)(O + r * ldc + c) = pack8(v0, v1); } }
        }
    }
};

template <class Epi, class Sched, bool ALIGN_EPI = false, bool SP2 = false>
__device__ __forceinline__ void gemm_phase(PG8_LAS unsigned char* lds, const Gemm g_in, const Sched& S, const Epi& E, int wave_in) {
    Gemm g = g_in; asm volatile("" : "+s"(g.A), "+s"(g.Bt));
    int lane_l; asm volatile("v_mbcnt_lo_u32_b32 %0, -1, 0\n\tv_mbcnt_hi_u32_b32 %0, -1, %0" : "=v"(lane_l));
    const int wid = __builtin_amdgcn_readfirstlane(wave_in), tid = wid * 64 + lane_l, lane = lane_l, wr = wid >> 2, wc = wid & 3, fr = lane & 15, fq = lane >> 4;
    const int K = g.K, nt = K / BK;
    unsigned voffA[2], voffB[2];
#pragma unroll
    for (int i = 0; i < 2; ++i) { int R, C; stage_rc(tid * 16 + i * 8192, R, C); const int Rb = Epi::PERM ? ((R & ~31) + perm32(R & 31)) : R;
        voffA[i] = (unsigned)(R * g.lda + C) * 2u; voffB[i] = (unsigned)(Rb * g.ldb + C) * 2u; }
    const size_t kstep = (size_t)(BK * 2);
    const size_t hstepA = (size_t)HALF * g.lda * 2, hstepB = (size_t)HALF * g.ldb * 2;
    const unsigned ldsw = (unsigned)wid * 1024u;
    const int aoff = lds_byte(wr * 64 + fr, fq * 8), boff = lds_byte(wc * 32 + fr, fq * 8);
#define PG8_SA(b, h) (((b) * 2 + (h)) * HTB)
#define PG8_SB(b, h) ((4 + (b) * 2 + (h)) * HTB)
#define PG8_STAGE(bufoff, gbase, voff) do { _Pragma("unroll") for (int _i = 0; _i < 2; ++_i) \
        __builtin_amdgcn_global_load_lds((const unsigned*)((const char*)(gbase) + (voff)[_i]), (PG8_LAS unsigned*)(lds + (bufoff) + ldsw + _i * 8192), 16, 0, 0); } while (0)
#define PG8_LDA(dst, b, h) do { _Pragma("unroll") for (int m = 0; m < 4; ++m) _Pragma("unroll") for (int k = 0; k < 2; ++k) dst[m][k] = *(const PG8_LAS bf16x8*)(lds + PG8_SA(b, h) + aoff + m * 2048 + k * 1024); } while (0)
#define PG8_LDB(dst, b, h) do { _Pragma("unroll") for (int n = 0; n < 2; ++n) _Pragma("unroll") for (int k = 0; k < 2; ++k) dst[n][k] = *(const PG8_LAS bf16x8*)(lds + PG8_SB(b, h) + boff + n * 2048 + k * 1024); } while (0)
#define PG8_MMA(ai, bj, At, Bt) do { __builtin_amdgcn_s_setprio(1); _Pragma("unroll") for (int m = 0; m < 4; ++m) _Pragma("unroll") for (int n = 0; n < 2; ++n) _Pragma("unroll") for (int k = 0; k < 2; ++k) \
        acc[ai][bj][m][n] = __builtin_amdgcn_mfma_f32_16x16x32_bf16(Bt[n][k], At[m][k], acc[ai][bj][m][n], 0, 0, 0); __builtin_amdgcn_s_setprio(0); } while (0)
#define PG8_WAIT_V(n) asm volatile("s_waitcnt vmcnt(" #n ")" ::: "memory")
#define PG8_WAIT_L(n) asm volatile("s_waitcnt lgkmcnt(" #n ")" ::: "memory")
#define PG8_BAR __builtin_amdgcn_s_barrier()
#define PG8_SCHED __builtin_amdgcn_sched_barrier(0)
    Unit cur, nxt; int ui = 0;
    if (!S.next(0, cur)) return;
    f32x4 acc[2][2][4][2];
#pragma unroll
    for (int a = 0; a < 2; ++a)
#pragma unroll
        for (int b = 0; b < 2; ++b)
#pragma unroll
            for (int m = 0; m < 4; ++m)
#pragma unroll
                for (int n = 0; n < 2; ++n) acc[a][b][m][n] = (f32x4){0.f, 0.f, 0.f, 0.f};
    bf16x8 At[4][2], B0[2][2], B1[2][2];
    const char* cA = g.pa(cur); const char* cB = g.pb(cur);
    S.a_ready(cur);
    if constexpr (SP2) {
        PG8_STAGE(PG8_SB(0, 0), cB, voffB); PG8_STAGE(PG8_SB(0, 1), cB + hstepB, voffB); PG8_STAGE(PG8_SA(0, 0), cA, voffA); PG8_STAGE(PG8_SA(0, 1), cA + hstepA, voffA);
        if (wr == 1) PG8_BAR;
        PG8_WAIT_V(2); PG8_BAR;
        PG8_STAGE(PG8_SB(1, 0), cB + kstep, voffB); PG8_STAGE(PG8_SA(1, 0), cA + kstep, voffA); PG8_STAGE(PG8_SB(1, 1), cB + hstepB + kstep, voffB);
        PG8_WAIT_V(6); PG8_BAR;
    } else {
        PG8_STAGE(PG8_SB(0, 0), cB, voffB); PG8_STAGE(PG8_SA(0, 0), cA, voffA); PG8_STAGE(PG8_SB(0, 1), cB + hstepB, voffB); PG8_STAGE(PG8_SA(0, 1), cA + hstepA, voffA);
        if (wr == 1) PG8_BAR;
        PG8_WAIT_V(4); PG8_BAR;
        PG8_STAGE(PG8_SB(1, 0), cB + kstep, voffB); PG8_STAGE(PG8_SA(1, 0), cA + kstep, voffA); PG8_STAGE(PG8_SB(1, 1), cB + hstepB + kstep, voffB);
        PG8_WAIT_V(6); PG8_BAR;
    }
    for (;;) {
        const bool has_next = S.next(ui + 1, nxt);
        const char* nA = has_next ? g.pa(nxt) : cA; const char* nB = has_next ? g.pb(nxt) : cB;
#pragma unroll 1
        for (int t = 0; t < nt; t += 2) {
            const bool last = (t == nt - 2);
            const char* a1 = cA + (size_t)(t + 1) * kstep;
            const char* a2 = last ? nA : cA + (size_t)(t + 2) * kstep; const char* b2 = last ? nB : cB + (size_t)(t + 2) * kstep;
            const char* a3 = a2 + kstep; const char* b3 = b2 + kstep;
            if (last && has_next) S.a_ready(nxt);
            if constexpr (SP2) {
            PG8_LDB(B0, 0, 0); PG8_LDB(B1, 0, 1); PG8_SCHED; PG8_LDA(At, 0, 0); PG8_STAGE(PG8_SA(1, 1), a1 + hstepA, voffA);
            PG8_WAIT_V(8); PG8_WAIT_L(0); PG8_BAR; PG8_MMA(0, 0, At, B0); PG8_MMA(0, 1, At, B1); PG8_BAR; PG8_SCHED;
            PG8_LDA(At, 0, 1); PG8_STAGE(PG8_SB(0, 0), b2, voffB); PG8_STAGE(PG8_SB(0, 1), b2 + hstepB, voffB); PG8_STAGE(PG8_SA(0, 0), a2, voffA);
            PG8_WAIT_V(8); PG8_WAIT_L(0); PG8_BAR; PG8_MMA(1, 0, At, B0); PG8_MMA(1, 1, At, B1); PG8_BAR; PG8_SCHED;
            PG8_LDB(B0, 1, 0); PG8_LDB(B1, 1, 1); PG8_SCHED; PG8_LDA(At, 1, 0); PG8_STAGE(PG8_SA(0, 1), a2 + hstepA, voffA);
            PG8_WAIT_V(8); PG8_WAIT_L(0); PG8_BAR; PG8_MMA(0, 0, At, B0); PG8_MMA(0, 1, At, B1); PG8_BAR; PG8_SCHED;
            PG8_LDA(At, 1, 1); PG8_STAGE(PG8_SB(1, 0), b3, voffB); PG8_STAGE(PG8_SB(1, 1), b3 + hstepB, voffB); PG8_STAGE(PG8_SA(1, 0), a3, voffA);
            PG8_WAIT_V(8); PG8_WAIT_L(0); PG8_BAR; PG8_MMA(1, 0, At, B0); PG8_MMA(1, 1, At, B1); PG8_BAR; PG8_SCHED;
            } else {
            PG8_LDB(B0, 0, 0); PG8_SCHED; PG8_LDA(At, 0, 0); PG8_STAGE(PG8_SA(1, 1), a1 + hstepA, voffA);
            PG8_WAIT_L(8); PG8_BAR; PG8_WAIT_L(0); PG8_MMA(0, 0, At, B0); PG8_BAR; PG8_SCHED;
            PG8_LDB(B1, 0, 1); PG8_STAGE(PG8_SB(0, 0), b2, voffB);
            PG8_BAR; PG8_WAIT_L(0); PG8_MMA(0, 1, At, B1); PG8_BAR;
            PG8_LDA(At, 0, 1); PG8_STAGE(PG8_SA(0, 0), a2, voffA);
            PG8_BAR; PG8_WAIT_L(0); PG8_MMA(1, 0, At, B0); PG8_BAR; PG8_SCHED;
            PG8_STAGE(PG8_SB(0, 1), b2 + hstepB, voffB);
            PG8_WAIT_V(6); PG8_BAR; PG8_MMA(1, 1, At, B1); PG8_BAR;
            PG8_LDB(B0, 1, 0); PG8_SCHED; PG8_LDA(At, 1, 0); PG8_STAGE(PG8_SA(0, 1), a2 + hstepA, voffA);
            PG8_WAIT_L(8); PG8_BAR; PG8_WAIT_L(0); PG8_MMA(0, 0, At, B0); PG8_BAR; PG8_SCHED;
            PG8_LDB(B1, 1, 1); PG8_STAGE(PG8_SB(1, 0), b3, voffB);
            PG8_BAR; PG8_WAIT_L(0); PG8_MMA(0, 1, At, B1); PG8_BAR;
            PG8_LDA(At, 1, 1); PG8_STAGE(PG8_SA(1, 0), a3, voffA);
            PG8_BAR; PG8_WAIT_L(0); PG8_MMA(1, 0, At, B0); PG8_BAR; PG8_SCHED;
            PG8_STAGE(PG8_SB(1, 1), b3 + hstepB, voffB);
            PG8_WAIT_V(6); PG8_BAR; PG8_MMA(1, 1, At, B1); PG8_BAR;
            }
        }
        if constexpr (ALIGN_EPI) { if (wr == 0) PG8_BAR; }
        if constexpr (!Epi::AFTER_DRAIN) { E(acc, cur, wr, wc, fr, fq); S.done(cur); }
        if (!has_next) break;
#pragma unroll
        for (int a = 0; a < 2; ++a)
#pragma unroll
            for (int b = 0; b < 2; ++b)
#pragma unroll
                for (int m = 0; m < 4; ++m)
#pragma unroll
                    for (int n = 0; n < 2; ++n) acc[a][b][m][n] = (f32x4){0.f, 0.f, 0.f, 0.f};
        cur = nxt; cA = nA; cB = nB; ++ui;
        if constexpr (ALIGN_EPI) { if (wr == 1) PG8_BAR; }
    }
    PG8_WAIT_V(0);
    if constexpr (!ALIGN_EPI) { if (wr == 0) PG8_BAR; }
    PG8_BAR;
    if constexpr (Epi::AFTER_DRAIN) { E.fused(acc, cur, wr, wc, fr, fq, lds, wid, lane); S.done(cur); }
#undef PG8_SA
#undef PG8_SB
#undef PG8_STAGE
#undef PG8_LDA
#undef PG8_LDB
#undef PG8_MMA
#undef PG8_WAIT_V
#undef PG8_WAIT_L
#undef PG8_BAR
#undef PG8_SCHED
}

}
#ifndef USE_MFMA_SC
#define USE_MFMA_SC 1
#endif
#ifndef USE_MFMA_AT
#define USE_MFMA_AT 1
#endif

constexpr int NWAVES = 8, NTHR = NWAVES * 64;
constexpr int D = 2048, BATCH = 4, SEQ = 2048, DEPTH = 4, M = BATCH * SEQ;
constexpr int INW = 6736, INWP = 6912, GW = 3 * D, N1 = INWP + GW, FF = 8192, NPJ = INWP / 256;
constexpr int O_UPOOL = 0, O_UCONV = 1024, O_CG = 2048, O_BG = 3072, O_Q = 4096, O_K = 5120, O_V = 5376, O_QI = 5632, O_KI = 6656, O_WI = 6720;
constexpr int NH = 8, HD = 128, IH = 16, IDIM = 64, TOPK = 256;
constexpr float EPS = 1e-6f;
constexpr int NPH = 9;

constexpr size_t MiB = 1u << 20;
constexpr size_t WS_CTL = 0, CTL_ZERO_BYTES = 1 * MiB;
constexpr size_t WS_WCAT1 = 1 * MiB;
constexpr size_t WS_WPOOL = 52 * MiB;
constexpr size_t WS_WBR = 53 * MiB;
constexpr size_t WS_WOUT = 65 * MiB;
constexpr size_t WS_WUP = 73 * MiB;
constexpr size_t WS_WDOWN = 105 * MiB;
constexpr size_t WS_H = 137 * MiB;
constexpr size_t WS_PROJ = 169 * MiB;
constexpr size_t WS_GATES = 277 * MiB;
constexpr size_t WS_ABUF = WS_PROJ;
constexpr size_t WS_DP = 373 * MiB;
constexpr size_t WS_Y = 389 * MiB;
constexpr size_t WS_SC = 437 * MiB;
constexpr size_t WS_MASK = 501 * MiB;
constexpr size_t WS_TMP = 503 * MiB;
constexpr size_t WS_MP = 567 * MiB;
constexpr size_t WS_MX = 599 * MiB;
constexpr size_t WS_WBRX = 663 * MiB;
constexpr size_t WS_END = 667 * MiB;
static_assert(WS_WCAT1 + (size_t)N1 * D * 2 <= WS_WPOOL && WS_PROJ + (size_t)M * INWP * 2 <= WS_GATES && WS_GATES + (size_t)M * GW * 2 <= WS_DP && WS_ABUF + (size_t)M * FF * 2 <= WS_DP, "ws map");
constexpr int CW_BAR = 4096;

constexpr int RING_OFF = 0, RING_BYTES = 131072;
constexpr int LDSCTL_OFF = RING_BYTES, MISC_OFF = LDSCTL_OFF + 320;
constexpr int LDS_BYTES = 147456;

#define GAS __attribute__((address_space(1)))
#define LAS __attribute__((address_space(3)))
typedef unsigned short bf16;
typedef unsigned v4u __attribute__((ext_vector_type(4)));
typedef unsigned v2u __attribute__((ext_vector_type(2)));
typedef float f32x4 __attribute__((ext_vector_type(4)));
#define LDS_WAIT() asm volatile("s_waitcnt lgkmcnt(0)" ::: "memory")
#define VM_WAIT() asm volatile("s_waitcnt vmcnt(0)" ::: "memory")
__device__ __forceinline__ unsigned f2bf(float f) { unsigned u = __builtin_bit_cast(unsigned, f); return (u + 0x7fffu + ((u >> 16) & 1u)) >> 16; }
__device__ __forceinline__ unsigned pk2(float lo, float hi) { return f2bf(lo) | (f2bf(hi) << 16); }
__device__ __forceinline__ float bflo(unsigned w) { return __builtin_bit_cast(float, w << 16); }
__device__ __forceinline__ float bfhi(unsigned w) { return __builtin_bit_cast(float, w & 0xffff0000u); }
__device__ __forceinline__ float bf2f(bf16 b) { return __builtin_bit_cast(float, (unsigned)b << 16); }
__device__ __forceinline__ void unpack8(const v4u w, float (&f)[8]) { f[0] = bflo(w.x); f[1] = bfhi(w.x); f[2] = bflo(w.y); f[3] = bfhi(w.y); f[4] = bflo(w.z); f[5] = bfhi(w.z); f[6] = bflo(w.w); f[7] = bfhi(w.w); }
__device__ __forceinline__ int lane_id() { int l; asm volatile("v_mbcnt_lo_u32_b32 %0, -1, 0\n\tv_mbcnt_hi_u32_b32 %0, -1, %0" : "=v"(l)); return l; }
__device__ __forceinline__ float wave_sum(float v) {
#pragma unroll
    for (int o = 1; o < 64; o <<= 1) v += __shfl_xor(v, o);
    return v;
}

#define XB_TMO      128
#define XB_XCNT(j)  (256  + 64 * (j))
#define XB_XSUB(j)  (1280 + 64 * (j))
#define XB_XGEN(j)  (2304 + 64 * (j))
#define XB_TOP      3328
#define XB_TOPGEN   3392
#define XCD_BAR_WORDS 3456
#define XB_SPIN_CAP (1u << 18)

__device__ __forceinline__ unsigned xb_ld(unsigned* p)              { return __hip_atomic_load(p, __ATOMIC_RELAXED, __HIP_MEMORY_SCOPE_AGENT); }
__device__ __forceinline__ unsigned xb_add(unsigned* p, unsigned v) { return __hip_atomic_fetch_add(p, v, __ATOMIC_RELAXED, __HIP_MEMORY_SCOPE_AGENT); }
__device__ __forceinline__ unsigned xb_xcc_id() { return (unsigned)__builtin_amdgcn_s_getreg((3 << 11) | 20) & 0xFu; }
#define XB_SPIN(cond, bar) do { unsigned _sp = 0; while (cond) { __builtin_amdgcn_s_sleep(1); \
    if ((++_sp & 255u) == 0u) { if (xb_ld(&(bar)[XB_TMO])) break; if (_sp > XB_SPIN_CAP) { atomicAdd(&(bar)[XB_TMO], 1u); break; } } } } while (0)

struct XcdBarrier {
    unsigned* bar; unsigned x;
    volatile LAS unsigned* st;
};

__device__ __forceinline__ XcdBarrier xcd_barrier_post(unsigned* bar, volatile LAS unsigned* st) {
    XcdBarrier b; b.bar = bar; b.x = xb_xcc_id(); b.st = st;
    if (threadIdx.x == 0) (void)xb_add(&bar[XB_XCNT(b.x)], 1u);
    return b;
}
__device__ __forceinline__ void xcd_barrier_complete(unsigned* bar, unsigned x, unsigned& nloc, unsigned& nx) {
    const unsigned G = gridDim.x * gridDim.y * gridDim.z;
    unsigned sum, cnt, mine, sp = 0u;
    for (;;) {
        sum = 0u; cnt = 0u; mine = 0u;
#pragma unroll
        for (unsigned j = 0; j < 16; ++j) { const unsigned c = xb_ld(&bar[XB_XCNT(j)]); sum += c; cnt += (c > 0u) ? 1u : 0u; mine = (j == x) ? c : mine; }
        if (sum == G) break;
        __builtin_amdgcn_s_sleep(1);
        if ((++sp & 255u) == 0u) { if (xb_ld(&bar[XB_TMO])) break; if (sp > XB_SPIN_CAP) { atomicAdd(&bar[XB_TMO], 1u); break; } }
    }
    nloc = mine > 0u ? mine : 1u; nx = cnt > 0u ? cnt : 1u;
}

__device__ __forceinline__ void xcd_barrier(const XcdBarrier& b) {
    asm volatile("s_waitcnt vmcnt(0)" ::: "memory");
    __syncthreads();
    if (threadIdx.x == 0) {
        unsigned* bar = b.bar;
        __builtin_amdgcn_s_waitcnt(0);
        unsigned nloc = b.st[0], nx = b.st[1];
        if (nloc == 0u) { xcd_barrier_complete(bar, b.x, nloc, nx); b.st[0] = nloc; b.st[1] = nx; }
        const unsigned old = xb_add(&bar[XB_XSUB(b.x)], 1u);
        const unsigned gen = old / nloc;
        if (old + 1u == (gen + 1u) * nloc) {
            __builtin_amdgcn_fence(__ATOMIC_RELEASE, "agent");
            asm volatile("s_waitcnt vmcnt(0)" ::: "memory");
            const unsigned og = xb_add(&bar[XB_TOP], 1u);
            const unsigned tg = og / nx;
            if (og + 1u == (tg + 1u) * nx) xb_add(&bar[XB_TOPGEN], 1u);
            else XB_SPIN(xb_ld(&bar[XB_TOPGEN]) == tg, bar);
            __builtin_amdgcn_fence(__ATOMIC_ACQUIRE, "agent");
            xb_add(&bar[XB_XGEN(b.x)], 1u);
            asm volatile("s_waitcnt vmcnt(0)" ::: "memory");
        } else {
            XB_SPIN(xb_ld(&bar[XB_XGEN(b.x)]) == gen, bar);
            __builtin_amdgcn_fence(__ATOMIC_ACQUIRE, "agent");
            asm volatile("s_waitcnt vmcnt(0)" ::: "memory");
        }
    }
    __syncthreads();
}


struct Frame {
    LAS unsigned char* lds;
    volatile LAS unsigned* MISC;
    unsigned* ctl;
    int wave, vcu, G;
    const float *x_in, *gains, *w_in, *pool_w, *pool_scale, *conv_w, *rel_bias, *w_branch, *w_gate, *b_gate, *w_out, *w_up, *w_down;
    float* out;
    bf16 *Wcat1, *Wpool, *Wbr, *Wbrx, *Wout, *Wup, *Wdown;
    bf16 *Hb, *PROJ, *GATES, *ABUF, *DP, *Y, *MP;
    float *SC, *TMP; bf16* MXB;
    unsigned long long* MASK;
};

__device__ __forceinline__ void conv_item(const float* W, int K, int Nsrc, int nblk, bf16* WT, LAS float* scr, int item, int lane) {
    const int kb = item / nblk, nb = item - kb * nblk, k0 = 64 * kb, n0 = 32 * nb;
    const int nl = n0 + (lane & 31); const bool ok = nl < Nsrc;
    float wv_[32];
#pragma unroll
    for (int i = 0; i < 32; ++i) { const int kk = 2 * i + (lane >> 5); wv_[i] = ok ? __builtin_nontemporal_load(W + (size_t)(k0 + kk) * Nsrc + nl) : 0.f; }
#pragma unroll
    for (int i = 0; i < 32; ++i) { const int kk = 2 * i + (lane >> 5); scr[kk * 33 + (lane & 31)] = wv_[i]; }
    LDS_WAIT(); asm volatile("" ::: "memory");
    const int c = lane & 7;
#pragma unroll
    for (int j = 0; j < 4; ++j) { const int n = (lane >> 3) + 8 * j; const LAS float* s = scr + (8 * c) * 33 + n;
        v4u o; o.x = pk2(s[0 * 33], s[1 * 33]); o.y = pk2(s[2 * 33], s[3 * 33]); o.z = pk2(s[4 * 33], s[5 * 33]); o.w = pk2(s[6 * 33], s[7 * 33]);
        *(GAS v4u*)(WT + (size_t)(n0 + n) * K + k0 + 8 * c) = o; }
    LDS_WAIT(); asm volatile("" ::: "memory");
}
template <int PART> __device__ __forceinline__ void convert_weights(Frame& F, int l, int wg_lo) {
    int lane = lane_id(); asm volatile("" : "+v"(lane));
    LAS float* scr = (LAS float*)(F.lds + RING_OFF + F.wave * 16384);
    constexpr int I0 = 32 * 216, I1 = 32 * 192, I2 = 4 * 32, I3 = 3 * 1024, I4 = 32 * 64, I5 = 32 * 256, I6 = 128 * 64;
    if (PART == 0) {
        const int gw = F.vcu * NWAVES + F.wave, NGW = F.G * NWAVES;
        for (int it = gw; it < I0 + I1 + I2 + I3; it += NGW) {
            int r = it;
            if (r < I0) { conv_item(F.w_in + (size_t)l * D * INW, D, INW, 216, F.Wcat1, scr, r, lane); continue; } r -= I0;
            if (r < I1) { conv_item(F.w_gate + (size_t)l * D * GW, D, GW, 192, F.Wcat1 + (size_t)INWP * D, scr, r, lane); continue; } r -= I1;
            if (r < I2) { const int e0 = (r * 64 + lane) * 32;
#pragma unroll
                for (int q = 0; q < 8; ++q) { const int e = e0 + 4 * q; const f32x4 w = *(const f32x4*)(F.pool_w + (size_t)l * 262144 + e); const f32x4 sc = *(const f32x4*)(F.pool_scale + (size_t)l * 1024 + (e >> 16) * 256 + (e & 255));
                    v2u o; o.x = pk2(w.x * sc.x, w.y * sc.y); o.y = pk2(w.z * sc.z, w.w * sc.w); *(v2u*)(F.Wpool + e) = o; }
                continue; } r -= I2;
            { const int n = r >> 10; conv_item(F.w_branch + ((size_t)l * 3 + n) * 1024 * D, 1024, D, 64, n == 0 ? F.Wbrx : F.Wbr + (size_t)n * D * 1024, scr, r & 1023, lane); }
        }
    } else {
        if ((int)blockIdx.x < wg_lo) return;
        const int gw = ((int)blockIdx.x - wg_lo) * NWAVES + F.wave, NGW = (F.G - wg_lo) * NWAVES;
        for (int it = gw; it < I4 + I5 + I6; it += NGW) {
            int r = it;
            if (r < I4) { conv_item(F.w_out + (size_t)l * D * D, D, D, 64, F.Wout, scr, r, lane); continue; } r -= I4;
            if (r < I5) { conv_item(F.w_up + (size_t)l * D * FF, D, FF, 256, F.Wup, scr, r, lane); continue; } r -= I5;
            conv_item(F.w_down + (size_t)l * FF * D, FF, D, 64, F.Wdown, scr, r, lane);
        }
    }
}

__device__ __forceinline__ void store_h_row(bf16* orow, const f32x4 (&v)[8], const float* g, float rstd, int lane) {
    GAS v2u* o8 = (GAS v2u*)orow;
#pragma unroll
    for (int j = 0; j < 8; ++j) { const f32x4 gv = ((const f32x4*)g)[lane + 64 * j]; v2u w; w.x = pk2(v[j].x * rstd * gv.x, v[j].y * rstd * gv.y); w.y = pk2(v[j].z * rstd * gv.z, v[j].w * rstd * gv.w); o8[lane + 64 * j] = w; }
}
__device__ __forceinline__ void norm0_phase(Frame& F, const float* x, const float* g, bf16* h) {
    int lane = lane_id(); asm volatile("" : "+v"(lane));
    const int gw = F.vcu * NWAVES + F.wave, NGW = F.G * NWAVES;
    for (int row = gw; row < M; row += NGW) {
        f32x4 v[8]; float s = 0.f;
#pragma unroll
        for (int j = 0; j < 8; ++j) { v[j] = ((const f32x4*)(x + (size_t)row * D))[lane + 64 * j]; s += (v[j].x * v[j].x + v[j].y * v[j].y) + (v[j].z * v[j].z + v[j].w * v[j].w); }
        const float rstd = 1.0f / sqrtf(wave_sum(s) * (1.0f / D) + EPS);
        store_h_row(h + (size_t)row * D, v, g, rstd, lane);
    }
}
__device__ __forceinline__ void resnorm_phase(Frame& F, const float* xsrc, float* xdst, const bf16* mbuf, const float* g_post, const float* g_pre, bf16* h) {
    int lane = lane_id(); asm volatile("" : "+v"(lane));
    const int gw = F.vcu * NWAVES + F.wave, NGW = F.G * NWAVES;
    for (int row = gw; row < M; row += NGW) {
        f32x4 mv[8], xv[8]; float s = 0.f;
#pragma unroll
        for (int j = 0; j < 8; ++j) { const v2u mw = ((const v2u*)(mbuf + (size_t)row * D))[lane + 64 * j]; mv[j] = (f32x4){bflo(mw.x), bfhi(mw.x), bflo(mw.y), bfhi(mw.y)}; xv[j] = ((const f32x4*)(xsrc + (size_t)row * D))[lane + 64 * j];
            s += (mv[j].x * mv[j].x + mv[j].y * mv[j].y) + (mv[j].z * mv[j].z + mv[j].w * mv[j].w); }
        const float rstd = 1.0f / sqrtf(wave_sum(s) * (1.0f / D) + EPS);
        float s2 = 0.f;
#pragma unroll
        for (int j = 0; j < 8; ++j) { const f32x4 gv = ((const f32x4*)g_post)[lane + 64 * j]; xv[j] = xv[j] + mv[j] * gv * rstd;
            ((f32x4*)(xdst + (size_t)row * D))[lane + 64 * j] = xv[j];
            s2 += (xv[j].x * xv[j].x + xv[j].y * xv[j].y) + (xv[j].z * xv[j].z + xv[j].w * xv[j].w); }
        if (g_pre) { const float rstd2 = 1.0f / sqrtf(wave_sum(s2) * (1.0f / D) + EPS); store_h_row(h + (size_t)row * D, xv, g_pre, rstd2, lane); }
    }
}

template <int W> __device__ __forceinline__ void pool_item(Frame& F, int row, int t, int c8) {
    float s[8], u[8];
#pragma unroll
    for (int i = 0; i < 8; ++i) s[i] = 0.f;
    v4u ld[W];
#pragma unroll
    for (int k = 0; k < W; ++k) { const int kk = (t - k) >= 0 ? k : t; ld[k] = *(const v4u*)(F.PROJ + (size_t)(row - kk) * INWP + O_UPOOL + c8); }
#pragma unroll
    for (int k = W - 1; k >= 0; --k) { unpack8(ld[k], u); const float wgt = (t - k) >= 0 ? 1.f : 0.f;
#pragma unroll
        for (int i = 0; i < 8; ++i) s[i] += wgt * u[i]; }
    const int cnt = (t + 1) < W ? (t + 1) : W;
    const float inv = 1.0f / (float)cnt;
    v4u o; o.x = pk2(s[0] * inv - u[0], s[1] * inv - u[1]); o.y = pk2(s[2] * inv - u[2], s[3] * inv - u[3]); o.z = pk2(s[4] * inv - u[4], s[5] * inv - u[5]); o.w = pk2(s[6] * inv - u[6], s[7] * inv - u[7]);
    *(v4u*)(F.Y + (size_t)row * 1024 + c8) = o;
}
__device__ __forceinline__ void poolconv_phase(Frame& F, const float* conv_w_l) {
    int tid = F.wave * 64 + lane_id(); asm volatile("" : "+v"(tid));
    const int gt = F.vcu * NTHR + tid, NGT = F.G * NTHR;
    for (int idx = gt; idx < M * 128; idx += NGT) {
        const int grp = idx / (M * 32), rem = idx - grp * (M * 32), row = rem >> 5, c8 = grp * 256 + (rem & 31) * 8, t = row & (SEQ - 1);
        if (grp == 0) pool_item<2>(F, row, t, c8); else if (grp == 1) pool_item<4>(F, row, t, c8); else if (grp == 2) pool_item<8>(F, row, t, c8); else pool_item<16>(F, row, t, c8);
    }
    for (int idx = gt; idx < M * 128; idx += NGT) {
        const int row = idx >> 7, c8 = (idx & 127) * 8, t = row & (SEQ - 1);
        float acc[8], a[8], b[8];
#pragma unroll
        for (int i = 0; i < 8; ++i) acc[i] = 0.f;
        v4u la[3], lb[3];
#pragma unroll
        for (int j = 0; j < 3; ++j) { const int back = (t - 2 + j) >= 0 ? (2 - j) : 0; const bf16* pr = F.PROJ + (size_t)(row - back) * INWP; la[j] = *(const v4u*)(pr + O_CG + c8); lb[j] = *(const v4u*)(pr + O_UCONV + c8); }
        const v4u lg = *(const v4u*)(F.PROJ + (size_t)row * INWP + O_BG + c8);
#pragma unroll
        for (int j = 0; j < 3; ++j) { const float wgt = (t - 2 + j) >= 0 ? 1.f : 0.f; unpack8(la[j], a); unpack8(lb[j], b);
            const f32x4 w0 = *(const f32x4*)(conv_w_l + j * 1024 + c8) * wgt, w1 = *(const f32x4*)(conv_w_l + j * 1024 + c8 + 4) * wgt;
            acc[0] += w0.x * (a[0] * b[0]); acc[1] += w0.y * (a[1] * b[1]); acc[2] += w0.z * (a[2] * b[2]); acc[3] += w0.w * (a[3] * b[3]);
            acc[4] += w1.x * (a[4] * b[4]); acc[5] += w1.y * (a[5] * b[5]); acc[6] += w1.z * (a[6] * b[6]); acc[7] += w1.w * (a[7] * b[7]); }
        unpack8(lg, a);
        v4u o; o.x = pk2(a[0] * acc[0], a[1] * acc[1]); o.y = pk2(a[2] * acc[2], a[3] * acc[3]); o.z = pk2(a[4] * acc[4], a[5] * acc[5]); o.w = pk2(a[6] * acc[6], a[7] * acc[7]);
        *(v4u*)(F.Y + (size_t)M * 1024 + (size_t)row * 1024 + c8) = o;
    }
}

__device__ __forceinline__ void scores_phase_scalar(Frame& F) {
    int tid = F.wave * 64 + lane_id(); asm volatile("" : "+v"(tid));
    LAS float* qs = (LAS float*)(F.lds + RING_OFF);
    LAS float* wsm = (LAS float*)(F.lds + RING_OFF + 32768);
    for (int unit = blockIdx.x; unit < M / 8; unit += F.G) {
        const int row0 = unit * 8, b = row0 / SEQ, t0 = row0 % SEQ;
        __syncthreads();
        for (int i = tid; i < 8 * 1024; i += NTHR) qs[i] = bf2f(F.PROJ[(size_t)(row0 + (i >> 10)) * INWP + O_QI + (i & 1023)]);
        if (tid < 128) wsm[tid] = bf2f(F.PROJ[(size_t)(row0 + (tid >> 4)) * INWP + O_WI + (tid & 15)]) * 0.25f;
        __syncthreads();
        for (int s = tid; s <= t0 + 7; s += NTHR) {
            float kv[64];
            const bf16* kp = F.PROJ + (size_t)(b * SEQ + s) * INWP + O_KI;
#pragma unroll
            for (int c = 0; c < 8; ++c) { float t8[8]; unpack8(*(const v4u*)(kp + 8 * c), t8);
#pragma unroll
                for (int i = 0; i < 8; ++i) kv[8 * c + i] = t8[i]; }
            for (int r = 0; r < 8; ++r) {
                float tot = 0.f;
                for (int h = 0; h < IH; ++h) {
                    float dot = 0.f; const LAS float* qp = qs + r * 1024 + h * 64;
#pragma unroll
                    for (int d = 0; d < 64; ++d) dot = fmaf(qp[d], kv[d], dot);
                    tot += wsm[r * 16 + h] * fmaxf(dot, 0.f);
                }
                if (s <= t0 + r) F.SC[(size_t)(row0 + r) * SEQ + s] = tot;
            }
        }
    }
    __syncthreads();
}

__device__ __forceinline__ unsigned fkey(float f) { const unsigned u = __builtin_bit_cast(unsigned, f); return (u & 0x80000000u) ? ~u : (u | 0x80000000u); }
__device__ __forceinline__ int wave_isum(int v) {
#pragma unroll
    for (int o = 1; o < 64; o <<= 1) v += __shfl_xor(v, o);
    return v;
}
__device__ __forceinline__ void select_row(Frame& F, int row, int lane_) {
    int lane = lane_; asm volatile("" : "+v"(lane));
    {
        const int t = row & (SEQ - 1);
        const float* sr = F.SC + (size_t)row * SEQ;
        unsigned key[32];
#pragma unroll
        for (int j = 0; j < 32; ++j) { const int s = 64 * j + lane; key[j] = (s <= t) ? fkey(sr[s]) : 0u; }
        unsigned long long* mr = F.MASK + (size_t)row * 32;
        if (t + 1 <= TOPK) {
#pragma unroll
            for (int j = 0; j < 32; ++j) { const unsigned long long bm = __ballot(key[j] != 0u); if (lane == 0) mr[j] = bm; }
            return;
        }
        unsigned T = 0u; bool exact = false;
        for (int bit = 31; bit >= 0; --bit) {
            const unsigned cand = T | (1u << bit);
            int c = 0;
#pragma unroll
            for (int j = 0; j < 32; ++j) c += (key[j] >= cand) ? 1 : 0;
            c = wave_isum(c);
            if (c >= TOPK) { T = cand; if (c == TOPK) { exact = true; break; } }
        }
        if (exact) {
#pragma unroll
            for (int j = 0; j < 32; ++j) { const unsigned long long bm = __ballot(key[j] >= T); if (lane == 0) mr[j] = bm; }
            return;
        }
        int cg = 0;
#pragma unroll
        for (int j = 0; j < 32; ++j) cg += (key[j] > T) ? 1 : 0;
        cg = wave_isum(cg);
        const int need = TOPK - cg;
        int taken = 0;
#pragma unroll
        for (int j = 0; j < 32; ++j) {
            const unsigned long long eq = __ballot(key[j] == T);
            const int rank = taken + __popcll(eq & ((1ull << lane) - 1ull));
            const bool sel = (key[j] > T) || (key[j] == T && rank < need);
            taken += __popcll(eq);
            const unsigned long long bm = __ballot(sel);
            if (lane == 0) mr[j] = bm;
        }
    }
}

__device__ __forceinline__ int t5_bucket(int dist) {
    const int n = dist > 0 ? dist : 0;
    const float nf = (float)(n > 1 ? n : 1);
    int large = 16 + (int)(logf(nf / 16.0f) / 2.0794415416798357f * 16.0f);
    large = large < 31 ? large : 31;
    return n < 16 ? n : large;
}

__device__ __forceinline__ void attn_phase_scalar(Frame& F) {
    int lane = lane_id(); asm volatile("" : "+v"(lane));
    const int gw = F.vcu * NWAVES + F.wave, NGW = F.G * NWAVES;
    bf16* YA = F.Y + (size_t)2 * M * 1024;
    for (int item = gw; item < M * NH; item += NGW) {
        const int row = item >> 3, h = item & 7, g = h >> 2, b = row / SEQ, t = row % SEQ;
        const unsigned qw = *(const unsigned*)(F.PROJ + (size_t)row * INWP + O_Q + h * HD + 2 * lane);
        const float q0 = bflo(qw), q1 = bfhi(qw);
        const unsigned long long* mr = F.MASK + (size_t)row * 32;
        float mx = -INFINITY, l = 0.f, o0 = 0.f, o1 = 0.f;
        const float scale = 0.08838834764831845f;
        for (int j = 0; j <= (t >> 6); ++j) {
            unsigned long long w = mr[j];
            while (w) {
                const int bpos = __ffsll((long long)w) - 1; w &= w - 1;
                const int s = 64 * j + bpos;
                if (s > t) continue;
                const bf16* kr = F.PROJ + (size_t)(b * SEQ + s) * INWP;
                const unsigned kw = *(const unsigned*)(kr + O_K + g * HD + 2 * lane), vw = *(const unsigned*)(kr + O_V + g * HD + 2 * lane);
                const float dot = wave_sum(q0 * bflo(kw) + q1 * bfhi(kw));
                const float logit = dot * scale + F.rel_bias[t5_bucket(t - s) * NH + h];
                const float nm = fmaxf(mx, logit);
                const float corr = __expf(mx - nm), p = __expf(logit - nm);
                l = l * corr + p; o0 = o0 * corr + p * bflo(vw); o1 = o1 * corr + p * bfhi(vw);
                mx = nm;
            }
        }
        const float inv = 1.0f / l;
        *(unsigned*)(YA + (size_t)row * 1024 + h * HD + 2 * lane) = pk2(o0 * inv, o1 * inv);
    }
}


typedef short bf16x8 __attribute__((ext_vector_type(8)));
typedef float f32x16 __attribute__((ext_vector_type(16)));
__device__ __forceinline__ void scores_phase_mfma(Frame& F) {
    const int wave = F.wave;
    for (int rep = 0; rep < 2; ++rep) {
        const int lane = lane_id(), c = lane & 15, q4 = lane >> 4;
        const int j = blockIdx.x, b = j >> 6, i = j & 63, tb = rep == 0 ? 127 - i : i, t0 = tb * 16, nt = tb + 1;
        const bf16* qrow = F.PROJ + (size_t)(b * SEQ + t0 + c) * INWP + O_QI + 8 * q4;
        bf16x8 qa[16][2];
#pragma unroll
        for (int h = 0; h < 16; ++h)
#pragma unroll
            for (int ks = 0; ks < 2; ++ks) qa[h][ks] = *(const bf16x8*)(qrow + h * 64 + 32 * ks);
        unsigned wvp[4][8];
#pragma unroll
        for (int r = 0; r < 4; ++r) { const bf16* wp = F.PROJ + (size_t)(b * SEQ + t0 + 4 * q4 + r) * INWP + O_WI; const v4u w0 = *(const v4u*)wp, w1 = *(const v4u*)(wp + 8);
            wvp[r][0] = w0.x; wvp[r][1] = w0.y; wvp[r][2] = w0.z; wvp[r][3] = w0.w; wvp[r][4] = w1.x; wvp[r][5] = w1.y; wvp[r][6] = w1.z; wvp[r][7] = w1.w; }
        const bf16* kbase = F.PROJ + (size_t)(b * SEQ + c) * INWP + O_KI + 8 * q4;
        float* srow = F.SC + (size_t)(b * SEQ + t0 + 4 * q4) * SEQ + c;
        bf16x8 kb0, kb1, kc0, kc1;
        if (wave < nt) { const bf16* kp = kbase + (size_t)(wave * 16) * INWP; kb0 = *(const bf16x8*)kp; kb1 = *(const bf16x8*)(kp + 32); }
        if (wave + NWAVES < nt) { const bf16* kp = kbase + (size_t)((wave + NWAVES) * 16) * INWP; kc0 = *(const bf16x8*)kp; kc1 = *(const bf16x8*)(kp + 32); }
        for (int kt = wave; kt < nt; kt += NWAVES) {
            const bf16x8 b0 = kb0, b1 = kb1; kb0 = kc0; kb1 = kc1;
            if (kt + 2 * NWAVES < nt) { const bf16* kp = kbase + (size_t)((kt + 2 * NWAVES) * 16) * INWP; kc0 = *(const bf16x8*)kp; kc1 = *(const bf16x8*)(kp + 32); }
            f32x4 tot = {0.f, 0.f, 0.f, 0.f};
#pragma unroll
            for (int h = 0; h < 16; ++h) {
                f32x4 acc = {0.f, 0.f, 0.f, 0.f};
                acc = __builtin_amdgcn_mfma_f32_16x16x32_bf16(qa[h][0], b0, acc, 0, 0, 0);
                acc = __builtin_amdgcn_mfma_f32_16x16x32_bf16(qa[h][1], b1, acc, 0, 0, 0);
#pragma unroll
                for (int r = 0; r < 4; ++r) tot[r] += ((h & 1) ? bfhi(wvp[r][h >> 1]) : bflo(wvp[r][h >> 1])) * fmaxf(acc[r], 0.f);
            }
#pragma unroll
            for (int r = 0; r < 4; ++r) srow[(size_t)r * SEQ + kt * 16] = tot[r];
        }
        __syncthreads();
        select_row(F, b * SEQ + t0 + 2 * wave, lane);
        select_row(F, b * SEQ + t0 + 2 * wave + 1, lane);
    }
}

constexpr int AT_KPITCH = 272, AT_VPITCH = 72;
constexpr int AT_KBUF = 0, AT_VBUF = 4 * 32 * AT_KPITCH, AT_LUT = AT_VBUF + 4 * 128 * AT_VPITCH, AT_MERGE = 0, AT_END = AT_LUT + 8 * 132 * 4;
static_assert(AT_MERGE + 4 * 66 * 64 * 4 <= AT_LUT && AT_END <= RING_BYTES, "attention LDS map");
__device__ __forceinline__ void attn_phase_mfma(Frame& F) {
    int tid = F.wave * 64 + lane_id(); asm volatile("" : "+v"(tid));
    const int lane = tid & 63, wave = F.wave, grp = wave >> 2, hr = wave & 3, c = lane & 31, hh = lane >> 5, tg = tid & 255;
    LAS unsigned char* KB0 = F.lds + RING_OFF + AT_KBUF + grp * (2 * 32 * AT_KPITCH);
    LAS unsigned char* VB0 = F.lds + RING_OFF + AT_VBUF + grp * (2 * 128 * AT_VPITCH);
    LAS float* LUT = (LAS float*)(F.lds + RING_OFF + AT_LUT);
    LAS float* MG = (LAS float*)(F.lds + RING_OFF + AT_MERGE) + hr * (66 * 64);
    const float LOG2E = 1.4426950408889634f, C1 = 0.08838834764831845f * 1.4426950408889634f;
    __syncthreads();
    for (int idx = tid; idx < 8 * 129; idx += NTHR) { const int hd = idx / 129, d = idx - hd * 129; LUT[hd * 132 + d] = F.rel_bias[t5_bucket(d) * NH + hd] * LOG2E; }
    __syncthreads();
    bf16* YA = F.Y + (size_t)2 * M * 1024;
    const unsigned* maskw = (const unsigned*)F.MASK;
    for (int rep = 0; rep < 2; ++rep) {
        const int j = blockIdx.x, bg = j >> 5, i = j & 31, qb = rep == 0 ? 63 - i : i, b = bg >> 1, g = bg & 1, h = 4 * g + hr;
        const int q0 = qb * 32, tq = q0 + c; const size_t row_q = (size_t)(b * SEQ + tq);
        bf16x8 qf[8];
#pragma unroll
        for (int ks = 0; ks < 8; ++ks) qf[ks] = *(const bf16x8*)(F.PROJ + row_q * INWP + O_Q + h * HD + 16 * ks + 8 * hh);
        f32x16 o[4];
#pragma unroll
        for (int db = 0; db < 4; ++db)
#pragma unroll
            for (int r = 0; r < 16; ++r) o[db][r] = 0.f;
        float m = -INFINITY, l = 0.f;
        const int nsteps = (qb + 2) >> 1;
        const bf16* kvb = F.PROJ + (size_t)(b * SEQ) * INWP + g * HD;
        v4u sk[2], sv[2]; unsigned mw = 0u, mwn = 0u;
#define AT_LOAD_TILE(kt_) do { _Pragma("unroll") for (int u = 0; u < 2; ++u) { const int ck = tg + 256 * u; sk[u] = *(const v4u*)(kvb + (size_t)((kt_) * 32 + (ck >> 4)) * INWP + O_K + (ck & 15) * 8); } \
            _Pragma("unroll") for (int u = 0; u < 2; ++u) sv[u] = *(const v4u*)(kvb + (size_t)((kt_) * 32 + 2 * (tg & 15) + u) * INWP + O_V + (tg >> 4) * 8); mwn = maskw[row_q * 64 + (kt_)]; } while (0)
#define AT_WRITE_TILE(buf_) do { LAS unsigned char* KBw = KB0 + (buf_) * (32 * AT_KPITCH); LAS unsigned char* VBw = VB0 + (buf_) * (128 * AT_VPITCH); \
            _Pragma("unroll") for (int u = 0; u < 2; ++u) { const int ck = tg + 256 * u; *(LAS v4u*)(KBw + (ck >> 4) * AT_KPITCH + (ck & 15) * 16) = sk[u]; } \
            const int kp = tg & 15, dc = tg >> 4; const unsigned a0[4] = {sv[0].x, sv[0].y, sv[0].z, sv[0].w}, a1[4] = {sv[1].x, sv[1].y, sv[1].z, sv[1].w}; \
            _Pragma("unroll") for (int e = 0; e < 4; ++e) { *(LAS unsigned*)(VBw + (dc * 8 + 2 * e) * AT_VPITCH + kp * 4) = (a0[e] & 0xffffu) | (a1[e] << 16); \
                *(LAS unsigned*)(VBw + (dc * 8 + 2 * e + 1) * AT_VPITCH + kp * 4) = (a0[e] >> 16) | (a1[e] & 0xffff0000u); } } while (0)
        if (grp <= qb) { AT_LOAD_TILE(grp); AT_WRITE_TILE(0); mw = mwn; }
        if (grp + 2 <= qb) AT_LOAD_TILE(grp + 2);
        asm volatile("s_waitcnt lgkmcnt(0)" ::: "memory"); __builtin_amdgcn_s_barrier(); asm volatile("" ::: "memory");
        for (int st = 0; st < nsteps; ++st) {
            const int kt = 2 * st + grp; const bool valid = kt <= qb;
            LAS unsigned char* KB = KB0 + (st & 1) * (32 * AT_KPITCH); LAS unsigned char* VB = VB0 + (st & 1) * (128 * AT_VPITCH);
            if (valid) {
                const int key0 = kt * 32;
                f32x16 s;
#pragma unroll
                for (int r = 0; r < 16; ++r) s[r] = 0.f;
#pragma unroll
                for (int ks = 0; ks < 8; ++ks) { const bf16x8 a = *(const LAS bf16x8*)(KB + c * AT_KPITCH + (16 * ks + 8 * hh) * 2); s = __builtin_amdgcn_mfma_f32_32x32x16_bf16(a, qf[ks], s, 0, 0, 0); }
                const bool far = (q0 - key0 - 31) >= 128;
                const float bfar = LUT[h * 132 + 128];
                float tmax = -INFINITY;
#pragma unroll
                for (int r = 0; r < 16; ++r) {
                    const int koff = (r & 3) + 8 * (r >> 2) + 4 * hh;
                    float bias = bfar;
                    if (!far) { int dist = tq - (key0 + koff); dist = dist < 0 ? 0 : (dist > 128 ? 128 : dist); bias = LUT[h * 132 + dist]; }
                    const float v = ((mw >> koff) & 1u) ? (s[r] * C1 + bias) : -INFINITY;
                    s[r] = v; tmax = fmaxf(tmax, v);
                }
                tmax = fmaxf(tmax, __shfl_xor(tmax, 32));
                const float mn = fmaxf(m, tmax), ms = (mn == -INFINITY) ? 0.f : mn;
                float rs = 0.f;
#pragma unroll
                for (int r = 0; r < 16; ++r) { const float p = __builtin_amdgcn_exp2f(s[r] - ms); s[r] = p; rs += p; }
                if (__any(mn != m)) {
                    const float corr = __builtin_amdgcn_exp2f(m - ms);
                    l *= corr;
#pragma unroll
                    for (int db = 0; db < 4; ++db)
#pragma unroll
                        for (int r = 0; r < 16; ++r) o[db][r] *= corr;
                }
                l += rs; m = mn;
                bf16x8 pf[2];
#pragma unroll
                for (int s2 = 0; s2 < 2; ++s2) { v4u w; w.x = pg8::cvt_pk_bf16(s[8 * s2 + 0], s[8 * s2 + 1]); w.y = pg8::cvt_pk_bf16(s[8 * s2 + 2], s[8 * s2 + 3]); w.z = pg8::cvt_pk_bf16(s[8 * s2 + 4], s[8 * s2 + 5]); w.w = pg8::cvt_pk_bf16(s[8 * s2 + 6], s[8 * s2 + 7]); pf[s2] = __builtin_bit_cast(bf16x8, w); }
#pragma unroll
                for (int db = 0; db < 4; ++db)
#pragma unroll
                    for (int s2 = 0; s2 < 2; ++s2) {
                        const LAS unsigned char* vp = VB + (32 * db + c) * AT_VPITCH + (16 * s2 + 4 * hh) * 2;
                        const v2u lo = *(const LAS v2u*)vp, hi = *(const LAS v2u*)(vp + 16);
                        v4u w; w.x = lo.x; w.y = lo.y; w.z = hi.x; w.w = hi.y;
                        o[db] = __builtin_amdgcn_mfma_f32_32x32x16_bf16(__builtin_bit_cast(bf16x8, w), pf[s2], o[db], 0, 0, 0);
                    }
            }
            if (kt + 2 <= qb) { AT_WRITE_TILE((st + 1) & 1); mw = mwn; }
            if (kt + 4 <= qb) AT_LOAD_TILE(kt + 4);
            asm volatile("s_waitcnt lgkmcnt(0)" ::: "memory"); __builtin_amdgcn_s_barrier(); asm volatile("" ::: "memory");
        }
#undef AT_LOAD_TILE
#undef AT_WRITE_TILE
        if (grp == 1) {
#pragma unroll
            for (int db = 0; db < 4; ++db)
#pragma unroll
                for (int r = 0; r < 16; ++r) MG[(db * 16 + r) * 64 + lane] = o[db][r];
            MG[64 * 64 + lane] = m; MG[65 * 64 + lane] = l;
        }
        __syncthreads();
        if (grp == 0) {
            const float m2 = MG[64 * 64 + lane], l2 = MG[65 * 64 + lane];
            const float mn = fmaxf(m, m2), ms = (mn == -INFINITY) ? 0.f : mn;
            const float fa = __builtin_amdgcn_exp2f(m - ms), fb = __builtin_amdgcn_exp2f(m2 - ms);
            float lt = l * fa + l2 * fb; lt += __shfl_xor(lt, 32);
            const float inv = 1.0f / lt;
            bf16* yp = YA + row_q * 1024 + h * HD + 4 * hh;
#pragma unroll
            for (int db = 0; db < 4; ++db)
#pragma unroll
                for (int rg = 0; rg < 4; ++rg) {
                    float v[4];
#pragma unroll
                    for (int e = 0; e < 4; ++e) v[e] = (o[db][4 * rg + e] * fa + MG[(db * 16 + 4 * rg + e) * 64 + lane] * fb) * inv;
                    v2u w; w.x = pg8::cvt_pk_bf16(v[0], v[1]); w.y = pg8::cvt_pk_bf16(v[2], v[3]);
                    *(v2u*)(yp + 32 * db + 8 * rg) = w;
                }
        }
        __syncthreads();
    }
}

struct Args { const float* in[13]; float* out; unsigned char* ws; int ph_lo, ph_hi; };
__global__ void __launch_bounds__(NTHR, 2) mk_fwd(Args args) {
    extern __shared__ __attribute__((aligned(16))) unsigned char lds[];
    Frame F;
    F.lds = (LAS unsigned char*)lds;
    F.MISC = (volatile LAS unsigned*)(F.lds + MISC_OFF);
    F.wave = __builtin_amdgcn_readfirstlane((int)threadIdx.x >> 6);
    F.G = gridDim.x; { const int bx = blockIdx.x; F.vcu = (F.G % 8 == 0) ? (bx % 8) * (F.G / 8) + bx / 8 : bx; }
    unsigned char* ws = args.ws;
    F.ctl = (unsigned*)(ws + WS_CTL);
    F.x_in = args.in[0]; F.gains = args.in[1]; F.w_in = args.in[2]; F.pool_w = args.in[3]; F.pool_scale = args.in[4]; F.conv_w = args.in[5]; F.rel_bias = args.in[6];
    F.w_branch = args.in[7]; F.w_gate = args.in[8]; F.b_gate = args.in[9]; F.w_out = args.in[10]; F.w_up = args.in[11]; F.w_down = args.in[12]; F.out = args.out;
    F.Wcat1 = (bf16*)(ws + WS_WCAT1); F.Wpool = (bf16*)(ws + WS_WPOOL); F.Wbr = (bf16*)(ws + WS_WBR); F.Wbrx = (bf16*)(ws + WS_WBRX); F.Wout = (bf16*)(ws + WS_WOUT); F.Wup = (bf16*)(ws + WS_WUP); F.Wdown = (bf16*)(ws + WS_WDOWN);
    F.Hb = (bf16*)(ws + WS_H); F.PROJ = (bf16*)(ws + WS_PROJ); F.GATES = (bf16*)(ws + WS_GATES); F.ABUF = (bf16*)(ws + WS_ABUF); F.DP = (bf16*)(ws + WS_DP); F.Y = (bf16*)(ws + WS_Y); F.MP = (bf16*)(ws + WS_MP);
    F.SC = (float*)(ws + WS_SC); F.TMP = (float*)(ws + WS_TMP); F.MXB = (bf16*)(ws + WS_MX); F.MASK = (unsigned long long*)(ws + WS_MASK);
    for (int u = (int)threadIdx.x; u < (LDS_BYTES - LDSCTL_OFF) / 4; u += NTHR) ((LAS unsigned*)(F.lds + LDSCTL_OFF))[u] = 0u;
    __syncthreads();
    XcdBarrier bar; bar.bar = F.ctl + CW_BAR; bar.x = 0; bar.st = nullptr;
    if (!MK_SPLIT) bar = xcd_barrier_post(F.ctl + CW_BAR, F.MISC + 8);
#define GRID_BAR() do { if (!MK_SPLIT) xcd_barrier(bar); } while (0)
    const int lo = args.ph_lo, hi = args.ph_hi;
#define IN(k) (lo <= (k) && (k) < hi)
    LAS unsigned char* ring = F.lds + RING_OFF;

    if (IN(0)) { convert_weights<0>(F, 0, 0); norm0_phase(F, F.x_in, F.gains, F.Hb); GRID_BAR(); }

    for (int l = 0; l < DEPTH; ++l) {
        const int pb = 1 + l * NPH;
        const float* g = F.gains + (size_t)l * 4 * D;
        if (IN(pb + 0)) {
            pg8::Gemm gm{F.Hb, F.Wcat1, D, D, D, 0, 0, 0}; pg8::StaticOrder S; S.init(M, N1, F.G, (int)blockIdx.x);
            pg8::EpiProjGate E{F.PROJ, INWP, F.GATES, GW, F.b_gate + (size_t)l * GW, NPJ};
            pg8::gemm_phase<pg8::EpiProjGate, pg8::StaticOrder, true, true>(ring, gm, S, E, F.wave);
            {
                const int wg_lo = (M / 256) * (N1 / 256) % F.G;
                if ((int)blockIdx.x >= wg_lo) { pg8::Gemm gf{F.Wbrx, F.Wpool, 1024, 256, 256, 256, 0, 0}; pg8::StaticOrder Sf; Sf.init(D, 1024, F.G, (int)blockIdx.x - wg_lo);
                    pg8::EpiBf16<0> Ef{F.Wbr, 1024, nullptr};
                    pg8::gemm_phase<pg8::EpiBf16<0>, pg8::StaticOrder, true, true>(ring, gf, Sf, Ef, F.wave); }
                convert_weights<1>(F, l, wg_lo);
            }
            GRID_BAR();
        }
        if (IN(pb + 1)) { poolconv_phase(F, F.conv_w + (size_t)l * 3 * 1024); if (USE_MFMA_SC) scores_phase_mfma(F); else scores_phase_scalar(F); GRID_BAR(); }
        if (IN(pb + 2)) { if (USE_MFMA_AT) attn_phase_mfma(F); else attn_phase_scalar(F); GRID_BAR(); }
        if (IN(pb + 3)) {
            pg8::Gemm gm{F.Y, F.Wbr, 1024, 1024, 1024, 0, (long)M * 1024, (long)D * 1024}; pg8::StaticOrder S; S.init(M, D, F.G, (int)blockIdx.x, 3);
            pg8::EpiBranch E{F.GATES, GW, D, F.TMP, F.MP, D, 3};
            pg8::gemm_phase<pg8::EpiBranch, pg8::StaticOrder, true, true>(ring, gm, S, E, F.wave);
            GRID_BAR();
        }
        if (IN(pb + 4)) {
            pg8::Gemm gm{F.MP, F.Wout, D, D, D, 0, 0, 0}; pg8::StaticOrder S; S.init(M, D, F.G, (int)blockIdx.x);
            pg8::EpiBf16<0> E{F.MXB, D, nullptr};
            pg8::gemm_phase<pg8::EpiBf16<0>, pg8::StaticOrder, true, true>(ring, gm, S, E, F.wave);
            GRID_BAR();
        }
        if (IN(pb + 5)) { resnorm_phase(F, l == 0 ? F.x_in : F.out, F.out, F.MXB, g + D, g + 2 * D, F.Hb); GRID_BAR(); }
        if (IN(pb + 6)) {
            pg8::Gemm gm{F.Hb, F.Wup, D, D, D, 0, 0, 0}; pg8::StaticOrder S; S.init(M, FF, F.G, (int)blockIdx.x);
            pg8::EpiBf16<1> E{F.ABUF, FF, nullptr};
            pg8::gemm_phase<pg8::EpiBf16<1>, pg8::StaticOrder, true, true>(ring, gm, S, E, F.wave);
            GRID_BAR();
        }
        if (IN(pb + 7)) {
            pg8::Gemm gm{F.ABUF, F.Wdown, FF, FF, FF, 0, 0, 0}; pg8::StaticOrder S; S.init(M, D, F.G, (int)blockIdx.x);
            pg8::EpiBf16<0> E{F.MXB, D, nullptr};
            pg8::gemm_phase<pg8::EpiBf16<0>, pg8::StaticOrder, true, true>(ring, gm, S, E, F.wave);
            GRID_BAR();
        }
        if (IN(pb + 8)) {
            if (l + 1 < DEPTH) { convert_weights<0>(F, l + 1, 0); resnorm_phase(F, F.out, F.out, F.MXB, g + 3 * D, g + 4 * D, F.Hb); GRID_BAR(); }
            else resnorm_phase(F, F.out, F.out, F.MXB, g + 3 * D, nullptr, nullptr);
        }
    }
#undef IN
#undef GRID_BAR
}

extern "C" void kernel_launch(void* const* d_in, const int* in_sizes, int n_in, void* d_out, int out_size, void* d_ws, size_t ws_size, hipStream_t stream) {
    static int grid = 0;
    if (grid == 0) {
        if (n_in != 13 || out_size != M * D || ws_size < WS_END) { fprintf(stderr, "kernel_launch: unexpected shapes (n_in %d out %d ws %zu need %zu); nothing launched\n", n_in, out_size, ws_size, (size_t)WS_END); grid = -1; return; }
        int dev = 0, cus = 0, per_cu = 0;
        if (hipGetDevice(&dev) != hipSuccess || hipDeviceGetAttribute(&cus, hipDeviceAttributeMultiprocessorCount, dev) != hipSuccess) { grid = -1; return; }
        if (hipFuncSetAttribute((const void*)mk_fwd, hipFuncAttributeMaxDynamicSharedMemorySize, LDS_BYTES) != hipSuccess) { fprintf(stderr, "kernel_launch: hipFuncSetAttribute failed\n"); grid = -1; return; }
        if (hipOccupancyMaxActiveBlocksPerMultiprocessor(&per_cu, (const void*)mk_fwd, NTHR, LDS_BYTES) != hipSuccess || per_cu < 1) { fprintf(stderr, "kernel_launch: occupancy query says %d\n", per_cu); }
        (void)hipGetLastError();
        grid = cus;
    }
    if (grid < 0) return;
    if (hipMemsetAsync((char*)d_ws + WS_CTL, 0, CTL_ZERO_BYTES, stream) != hipSuccess) return;
    Args a{};
    for (int i = 0; i < 13; ++i) a.in[i] = (const float*)d_in[i];
    a.out = (float*)d_out; a.ws = (unsigned char*)d_ws;
#if MK_SPLIT
    for (int p = 0; p < 1 + DEPTH * NPH; ++p) { a.ph_lo = p; a.ph_hi = p + 1; hipLaunchKernelGGL(mk_fwd, dim3(grid), dim3(NTHR), LDS_BYTES, stream, a); }
#else
    a.ph_lo = 0; a.ph_hi = 1 << 20;
    hipLaunchKernelGGL(mk_fwd, dim3(grid), dim3(NTHR), LDS_BYTES, stream, a);
#endif
}
```
